# Optimizing an MI355X kernel written in HIP

```python
import math
import jax, jax.numpy as jnp
from jax import lax
import numpy as np

D_MODEL = 2048
BATCH = 2
SEQ = 8192
DEPTH = 2

GRID_W = 64

HY_WIDTH = D_MODEL // 2
FILTER_EMB = 33
FILTER_BANDS = (FILTER_EMB - 1) // 2
FILTER_HIDDEN = 64
DECAY_TARGET = 1e-2
FAST_DECAY_PCT = 0.3
SLOW_DECAY_PCT = 1.5

HEAD_DIM = 128
N_HEADS = (D_MODEL // 2) // HEAD_DIM
N_KV_HEADS = 2
GROUP = N_HEADS // N_KV_HEADS
Q_WIDTH = N_HEADS * HEAD_DIM
KV_WIDTH = N_KV_HEADS * HEAD_DIM
ROPE_AXIS_DIM = HEAD_DIM // 2
ROPE_THETA = 10000.0
Q_BLOCK = 128

D_FF = 4 * D_MODEL

N_IN = 3 * HY_WIDTH + Q_WIDTH + 2 * KV_WIDTH + 2 * D_MODEL

ALPHA = (2 * DEPTH) ** 0.25
BETA = (8 * DEPTH) ** -0.25

LN_EPS = 1e-5
RMS_EPS = 1e-6

kernel_name = "hyena_axial_gqa_gated_hybrid_encoder"


def layer_norm(x, g, b):
    xf = x.astype(jnp.float32)
    mu = jnp.mean(xf, axis=-1, keepdims=True)
    var = jnp.mean(jnp.square(xf - mu), axis=-1, keepdims=True)
    return ((xf - mu) * lax.rsqrt(var + LN_EPS) * g + b).astype(x.dtype)


def rms_norm(x, g):
    xf = x.astype(jnp.float32)
    ms = jnp.mean(jnp.square(xf), axis=-1, keepdims=True)
    return (xf * lax.rsqrt(ms + RMS_EPS) * g).astype(x.dtype)


def short_conv_centred(z, w, b):
    zp = jnp.pad(z, ((0, 0), (1, 1), (0, 0)))
    return zp[:, :-2] * w[0] + zp[:, 1:-1] * w[1] + zp[:, 2:] * w[2] + b


def hyena_position_features(L):
    t = jnp.linspace(0.0, 1.0, L, dtype=jnp.float32)[:, None]
    w = 2.0 * math.pi * jnp.arange(L, dtype=jnp.float32) / L
    f = jnp.linspace(1e-4, FILTER_BANDS - 1, FILTER_BANDS, dtype=jnp.float32)
    ang = w[:, None] * f[None, :]
    return jnp.concatenate([t, jnp.cos(ang), -jnp.sin(ang)], axis=-1), t


def hyena_bidirectional_filter(feats, t, w1, b1, w2, b2, w3, freq):
    L = feats.shape[0]
    hdn = jnp.sin(freq * (feats @ w1 + b1))
    hdn = jnp.sin(freq * (hdn @ w2 + b2))
    h = (hdn @ w3).astype(jnp.float32).reshape(L, 2, HY_WIDTH)
    deltas = jnp.linspace(math.log(DECAY_TARGET) / FAST_DECAY_PCT,
                          math.log(DECAY_TARGET) / SLOW_DECAY_PCT,
                          HY_WIDTH, dtype=jnp.float32)
    decay = jnp.exp(-t * jnp.abs(deltas))
    h = h * decay[:, None, :]
    k = jnp.concatenate([h[:, 0], h[::-1, 1]], axis=0)
    return k / jnp.sum(jnp.abs(k), axis=0, keepdims=True)


def long_conv_fft(v, k, skip):
    L = v.shape[1]
    vf = v.astype(jnp.float32)
    V = jnp.fft.rfft(vf, n=2 * L, axis=1)
    K = jnp.fft.rfft(k, n=2 * L, axis=0)
    y = jnp.fft.irfft(V * K[None], n=2 * L, axis=1)[:, :L]
    return (y + vf * skip).astype(v.dtype)


def axial_rope_tables(L):
    rows = L // GRID_W
    row = jnp.broadcast_to(jnp.arange(rows)[:, None], (rows, GRID_W)).reshape(L)
    col = jnp.broadcast_to(jnp.arange(GRID_W)[None, :], (rows, GRID_W)).reshape(L)
    inv = ROPE_THETA ** (-jnp.arange(0, ROPE_AXIS_DIM, 2, dtype=jnp.float32) / ROPE_AXIS_DIM)
    ang = jnp.stack([row, col], axis=-1).astype(jnp.float32)[..., None] * inv
    return jnp.cos(ang), jnp.sin(ang)


def apply_axial_rope(x, cos, sin):
    xf = x.astype(jnp.float32).reshape(*x.shape[:-1], 2, 2, ROPE_AXIS_DIM // 2)
    x1, x2 = xf[..., 0, :], xf[..., 1, :]
    c, s = cos[None, :, None], sin[None, :, None]
    out = jnp.stack([x1 * c - x2 * s, x2 * c + x1 * s], axis=-2)
    return out.reshape(x.shape).astype(x.dtype)


def block_gqa_attention(q, k, v):
    B, L = q.shape[:2]
    nb = L // Q_BLOCK
    qb = jnp.moveaxis(q.reshape(B, nb, Q_BLOCK, N_KV_HEADS, GROUP, HEAD_DIM), 1, 0)
    scale = HEAD_DIM ** -0.5

    def one_block(qblk):
        s = jnp.einsum('bqkgd,bskd->bkgqs', qblk, k).astype(jnp.float32) * scale
        p = jax.nn.softmax(s, axis=-1).astype(v.dtype)
        return jnp.einsum('bkgqs,bskd->bqkgd', p, v)

    o = lax.map(one_block, qb)
    return jnp.moveaxis(o, 0, 1).reshape(B, L, Q_WIDTH)


def hybrid_mixer(u, feats, t, cos, sin, w_in, conv_w, conv_b, filt_w1, filt_b1,
                 filt_w2, filt_b2, filt_w3, filt_freq, filt_skip, q_norm, k_norm,
                 w_hy_out, w_attn_out, w_o):
    B, L, _ = u.shape
    proj = jnp.einsum('bld,dn->bln', u, w_in)
    cuts = np.cumsum([3 * HY_WIDTH, Q_WIDTH, KV_WIDTH, KV_WIDTH, D_MODEL]).tolist()
    hy, q, k, v, g_hy, g_at = jnp.split(proj, cuts, axis=-1)

    hy = short_conv_centred(hy, conv_w, conv_b)
    x0, x1, hv = jnp.split(hy, 3, axis=-1)
    kern = hyena_bidirectional_filter(feats, t, filt_w1, filt_b1, filt_w2, filt_b2,
                                      filt_w3, filt_freq)
    y_hy = x0 * long_conv_fft(hv * x1, kern, filt_skip)

    q = apply_axial_rope(rms_norm(q.reshape(B, L, N_HEADS, HEAD_DIM), q_norm), cos, sin)
    k = apply_axial_rope(rms_norm(k.reshape(B, L, N_KV_HEADS, HEAD_DIM), k_norm), cos, sin)
    y_at = block_gqa_attention(q.reshape(B, L, N_KV_HEADS, GROUP, HEAD_DIM), k,
                               v.reshape(B, L, N_KV_HEADS, HEAD_DIM))

    merged = (jax.nn.sigmoid(g_hy) * jnp.einsum('blc,cd->bld', y_hy, w_hy_out)
              + jax.nn.sigmoid(g_at) * jnp.einsum('blc,cd->bld', y_at, w_attn_out))
    return jnp.einsum('bld,de->ble', merged, w_o)


def setup_inputs(seed: int = 0) -> dict:
    key = jax.random.key(seed)
    ks = jax.random.split(key, 32)
    f32 = jnp.float32

    def nrm(k, shape, scale):
        return jax.random.normal(k, shape, f32) * scale

    def gain(k, shape):
        return 1.0 + 0.01 * jax.random.normal(k, shape, f32)

    return {
        "x": nrm(ks[0], (BATCH, SEQ, D_MODEL), 1.0),
        "emb_ln_g": gain(ks[1], (D_MODEL,)),
        "emb_ln_b": nrm(ks[2], (D_MODEL,), 0.01),
        "w_in": nrm(ks[3], (DEPTH, D_MODEL, N_IN), D_MODEL ** -0.5),
        "conv_w": nrm(ks[4], (DEPTH, 3, 3 * HY_WIDTH), 3 ** -0.5),
        "conv_b": nrm(ks[5], (DEPTH, 3 * HY_WIDTH), 0.02),
        "filt_w1": nrm(ks[6], (DEPTH, FILTER_EMB, FILTER_HIDDEN), FILTER_EMB ** -0.5),
        "filt_b1": nrm(ks[7], (DEPTH, FILTER_HIDDEN), 0.02),
        "filt_w2": nrm(ks[8], (DEPTH, FILTER_HIDDEN, FILTER_HIDDEN), FILTER_HIDDEN ** -0.5),
        "filt_b2": nrm(ks[9], (DEPTH, FILTER_HIDDEN), 0.02),
        "filt_w3": nrm(ks[10], (DEPTH, FILTER_HIDDEN, 2 * HY_WIDTH), FILTER_HIDDEN ** -0.5),
        "filt_freq": gain(ks[11], (DEPTH, FILTER_HIDDEN)),
        "filt_skip": nrm(ks[12], (DEPTH, HY_WIDTH), 1.0),
        "q_norm": gain(ks[13], (DEPTH, HEAD_DIM)),
        "k_norm": gain(ks[14], (DEPTH, HEAD_DIM)),
        "w_hy_out": nrm(ks[15], (DEPTH, HY_WIDTH, D_MODEL), HY_WIDTH ** -0.5),
        "w_attn_out": nrm(ks[16], (DEPTH, Q_WIDTH, D_MODEL), Q_WIDTH ** -0.5),
        "w_o": nrm(ks[17], (DEPTH, D_MODEL, D_MODEL), BETA * D_MODEL ** -0.5),
        "ln1_g": gain(ks[18], (DEPTH, D_MODEL)),
        "ln1_b": nrm(ks[19], (DEPTH, D_MODEL), 0.01),
        "w_up": nrm(ks[20], (DEPTH, D_MODEL, D_FF), D_MODEL ** -0.5),
        "w_down": nrm(ks[21], (DEPTH, D_FF, D_MODEL), BETA * D_FF ** -0.5),
        "ln2_g": gain(ks[22], (DEPTH, D_MODEL)),
        "ln2_b": nrm(ks[23], (DEPTH, D_MODEL), 0.01),
    }


def reference(x, emb_ln_g, emb_ln_b, w_in, conv_w, conv_b, filt_w1, filt_b1, filt_w2,
              filt_b2, filt_w3, filt_freq, filt_skip, q_norm, k_norm, w_hy_out,
              w_attn_out, w_o, ln1_g, ln1_b, w_up, w_down, ln2_g, ln2_b):
    L = x.shape[1]
    feats, t = hyena_position_features(L)
    cos, sin = axial_rope_tables(L)
    h = layer_norm(x, emb_ln_g, emb_ln_b)
    for i in range(DEPTH):
        mix = hybrid_mixer(h, feats, t, cos, sin, w_in[i], conv_w[i], conv_b[i],
                           filt_w1[i], filt_b1[i], filt_w2[i], filt_b2[i], filt_w3[i],
                           filt_freq[i], filt_skip[i], q_norm[i], k_norm[i],
                           w_hy_out[i], w_attn_out[i], w_o[i])
        h = layer_norm(ALPHA * h + mix, ln1_g[i], ln1_b[i])
        ff = jnp.einsum('blf,fd->bld',
                        jnp.square(jax.nn.relu(jnp.einsum('bld,df->blf', h, w_up[i]))),
                        w_down[i])
        h = layer_norm(ALPHA * h + ff, ln2_g[i], ln2_b[i])
    return h
```

```cpp
#include <hip/hip_runtime.h>
#include <hip/hip_bf16.h>
#include <hip/hip_cooperative_groups.h>
#include <cstdio>
#include <cstdint>
namespace cg = cooperative_groups;

constexpr int DM = 2048, NB = 2, SEQL = 8192, NTOK = NB * SEQL, DEPTH = 2, GRIDW = 64;
constexpr int HYW = 1024, FEMB = 33, FHID = 64, HD = 128, NH = 8, NKV = 2, QW = 1024, KVW = 256, DFF = 8192, NIN = 8704;
constexpr float ALPHA_F = 1.4142135623730951f;
constexpr float LN_EPS = 1e-5f, RMS_EPS = 1e-6f;
constexpr int NTHR = 512;

namespace pg8 {
#define PG8_LAS __attribute__((address_space(3)))
typedef unsigned short bf16_t;
typedef short bf16x8 __attribute__((ext_vector_type(8)));
typedef float f32x4 __attribute__((ext_vector_type(4)));
typedef unsigned u32x4 __attribute__((ext_vector_type(4)));
constexpr int BM = 256, BK = 64, HALF = 128, HTB = HALF * BK * 2  , STAGE_BYTES = 8 * HTB, NXCD = 8, WGM = 8;

__host__ __device__ __forceinline__ int lds_byte(int r, int c) { const int st = (r >> 4) * 2 + (c >> 5), rr = r & 15, cc = c & 31, ob = rr * 64 + cc * 2; return st * 1024 + (ob ^ (((ob >> 9) & 1) << 5)); }
__host__ __device__ __forceinline__ void stage_rc(int b, int& R, int& C) { const int st = b / 1024, sb = b % 1024, swz = sb ^ (((sb >> 9) & 1) << 5); R = (st >> 1) * 16 + swz / 64; C = (st & 1) * 32 + (swz % 64) / 2; }
__host__ __device__ __forceinline__ int perm32(int rho) { const int n = rho >> 4, i = rho & 15; return 8 * (i >> 2) + 4 * n + (i & 3); }

struct Unit { int pm, pn; };
struct Gemm { const bf16_t* A; const bf16_t* Bt; int M, N, K; };

struct StaticOrder {
    int nM, nN, nwg, G, c;
    __host__ __device__ void init(int M, int N, int G_, int c_) { nM = M / BM; nN = N / BM; nwg = nM * nN; G = G_; c = c_; }
    __host__ __device__ bool next(int i, Unit& u) const {
        const long L = (long)i * G + c; if (L >= nwg) return false;
        int wgid = (int)L; { const int q = nwg / NXCD, r = nwg % NXCD, xcd = wgid % NXCD, off = wgid / NXCD; wgid = (xcd < r ? xcd * (q + 1) : r * (q + 1) + (xcd - r) * q) + off; }
        const int nig = WGM * nN, gid = wgid / nig, fm = gid * WGM, gsz = (nM - fm) < WGM ? (nM - fm) : WGM;
        u.pm = fm + ((wgid % nig) % gsz); u.pn = (wgid % nig) / gsz; return true;
    }
    __device__ __forceinline__ void a_ready(const Unit&) const {}
    __device__ __forceinline__ void done(const Unit&) const {}
};
__device__ __forceinline__ unsigned cvt_pk_bf16(float lo, float hi) { unsigned r; asm volatile("v_cvt_pk_bf16_f32 %0, %1, %2" : "=v"(r) : "v"(lo), "v"(hi)); return r; }
template <class Epi, class Sched>
__device__ __forceinline__ void gemm_phase(PG8_LAS unsigned char* lds, const Gemm g, const Sched& S, const Epi& E) {
    int tid_ = threadIdx.x; asm volatile("" : "+v"(tid_)); const int tid = tid_, wid = __builtin_amdgcn_readfirstlane(tid >> 6), lane = tid & 63, wr = wid >> 2, wc = wid & 3, fr = lane & 15, fq = lane >> 4;
    const int K = g.K, nt = K / BK;
    unsigned voffA[2], voffB[2];
#pragma unroll
    for (int i = 0; i < 2; ++i) { int R, C; stage_rc(tid * 16 + i * 8192, R, C); const int Rb = Epi::PERM ? ((R & ~31) + perm32(R & 31)) : R;
        voffA[i] = (unsigned)(R * K + C) * 2u; voffB[i] = (unsigned)(Rb * K + C) * 2u; }
    const size_t kstep = (size_t)(BK * 2);
    const size_t hstep = (size_t)HALF * K * 2;
    const size_t tstep = 2 * hstep;
    const unsigned ldsw = (unsigned)wid * 1024u;
    const int aoff = lds_byte(wr * 64 + fr, fq * 8), boff = lds_byte(wc * 32 + fr, fq * 8);
#define PG8_SA(b, h) (((b) * 2 + (h)) * HTB)
#define PG8_SB(b, h) ((4 + (b) * 2 + (h)) * HTB)
#define PG8_STAGE(bufoff, gbase, voff) do { _Pragma("unroll") for (int _i = 0; _i < 2; ++_i) \
        __builtin_amdgcn_global_load_lds((const unsigned*)((const char*)(gbase) + (voff)[_i]), (PG8_LAS unsigned*)(lds + (bufoff) + ldsw + _i * 8192), 16, 0, 0); } while (0)
#define PG8_LDA(dst, b, h) do { _Pragma("unroll") for (int m = 0; m < 4; ++m) _Pragma("unroll") for (int k = 0; k < 2; ++k) dst[m][k] = *(const PG8_LAS bf16x8*)(lds + PG8_SA(b, h) + aoff + m * 2048 + k * 1024); } while (0)
#define PG8_LDB(dst, b, h) do { _Pragma("unroll") for (int n = 0; n < 2; ++n) _Pragma("unroll") for (int k = 0; k < 2; ++k) dst[n][k] = *(const PG8_LAS bf16x8*)(lds + PG8_SB(b, h) + boff + n * 2048 + k * 1024); } while (0)
#define PG8_MMA(ai, bj, At, Bt) do { __builtin_amdgcn_s_setprio(1); _Pragma("unroll") for (int m = 0; m < 4; ++m) _Pragma("unroll") for (int n = 0; n < 2; ++n) _Pragma("unroll") for (int k = 0; k < 2; ++k) \
        acc[ai][bj][m][n] = __builtin_amdgcn_mfma_f32_16x16x32_bf16(Bt[n][k], At[m][k], acc[ai][bj][m][n], 0, 0, 0); __builtin_amdgcn_s_setprio(0); } while (0)
#define PG8_WAIT_V(n) asm volatile("s_waitcnt vmcnt(" #n ")" ::: "memory")
#define PG8_WAIT_L(n) asm volatile("s_waitcnt lgkmcnt(" #n ")" ::: "memory")
#define PG8_BAR __builtin_amdgcn_s_barrier()
#define PG8_SCHED __builtin_amdgcn_sched_barrier(0)
    Unit cur, nxt; int ui = 0;
    if (!S.next(0, cur)) return;
    f32x4 acc[2][2][4][2];
#pragma unroll
    for (int a = 0; a < 2; ++a)
#pragma unroll
        for (int b = 0; b < 2; ++b)
#pragma unroll
            for (int m = 0; m < 4; ++m)
#pragma unroll
                for (int n = 0; n < 2; ++n) acc[a][b][m][n] = (f32x4){0.f, 0.f, 0.f, 0.f};
    bf16x8 At[4][2], B0[2][2], B1[2][2];
    const char* cA = (const char*)g.A + (size_t)cur.pm * tstep; const char* cB = (const char*)g.Bt + (size_t)cur.pn * tstep;
    S.a_ready(cur);
    PG8_STAGE(PG8_SB(0, 0), cB, voffB); PG8_STAGE(PG8_SA(0, 0), cA, voffA); PG8_STAGE(PG8_SB(0, 1), cB + hstep, voffB); PG8_STAGE(PG8_SA(0, 1), cA + hstep, voffA);
    if (wr == 1) PG8_BAR;
    PG8_WAIT_V(4); PG8_BAR;
    PG8_STAGE(PG8_SB(1, 0), cB + kstep, voffB); PG8_STAGE(PG8_SA(1, 0), cA + kstep, voffA); PG8_STAGE(PG8_SB(1, 1), cB + hstep + kstep, voffB);
    PG8_WAIT_V(6); PG8_BAR;
    for (;;) {
        const bool has_next = S.next(ui + 1, nxt);
        const char* nA = has_next ? (const char*)g.A + (size_t)nxt.pm * tstep : cA; const char* nB = has_next ? (const char*)g.Bt + (size_t)nxt.pn * tstep : cB;
        for (int t = 0; t < nt; t += 2) {
            const bool last = (t == nt - 2);
            const char* a1 = cA + (size_t)(t + 1) * kstep;
            const char* a2 = last ? nA : cA + (size_t)(t + 2) * kstep; const char* b2 = last ? nB : cB + (size_t)(t + 2) * kstep;
            const char* a3 = a2 + kstep; const char* b3 = b2 + kstep;
            if (last && has_next) S.a_ready(nxt);
            PG8_LDB(B0, 0, 0); PG8_SCHED; PG8_LDA(At, 0, 0); PG8_STAGE(PG8_SA(1, 1), a1 + hstep, voffA);
            PG8_WAIT_L(8); PG8_BAR; PG8_WAIT_L(0); PG8_MMA(0, 0, At, B0); PG8_BAR; PG8_SCHED;
            PG8_LDB(B1, 0, 1); PG8_STAGE(PG8_SB(0, 0), b2, voffB);
            PG8_BAR; PG8_WAIT_L(0); PG8_MMA(0, 1, At, B1); PG8_BAR;
            PG8_LDA(At, 0, 1); PG8_STAGE(PG8_SA(0, 0), a2, voffA);
            PG8_BAR; PG8_WAIT_L(0); PG8_MMA(1, 0, At, B0); PG8_BAR; PG8_SCHED;
            PG8_STAGE(PG8_SB(0, 1), b2 + hstep, voffB);
            PG8_WAIT_V(6); PG8_BAR; PG8_MMA(1, 1, At, B1); PG8_BAR;
            PG8_LDB(B0, 1, 0); PG8_SCHED; PG8_LDA(At, 1, 0); PG8_STAGE(PG8_SA(0, 1), a2 + hstep, voffA);
            PG8_WAIT_L(8); PG8_BAR; PG8_WAIT_L(0); PG8_MMA(0, 0, At, B0); PG8_BAR; PG8_SCHED;
            PG8_LDB(B1, 1, 1); PG8_STAGE(PG8_SB(1, 0), b3, voffB);
            PG8_BAR; PG8_WAIT_L(0); PG8_MMA(0, 1, At, B1); PG8_BAR;
            PG8_LDA(At, 1, 1); PG8_STAGE(PG8_SA(1, 0), a3, voffA);
            PG8_BAR; PG8_WAIT_L(0); PG8_MMA(1, 0, At, B0); PG8_BAR; PG8_SCHED;
            PG8_STAGE(PG8_SB(1, 1), b3 + hstep, voffB);
            PG8_WAIT_V(6); PG8_BAR; PG8_MMA(1, 1, At, B1); PG8_BAR;
        }
        if constexpr (!Epi::AFTER_DRAIN) { E(acc, cur, wr, wc, fr, fq); S.done(cur); }
        if (!has_next) break;
#pragma unroll
        for (int a = 0; a < 2; ++a)
#pragma unroll
            for (int b = 0; b < 2; ++b)
#pragma unroll
                for (int m = 0; m < 4; ++m)
#pragma unroll
                    for (int n = 0; n < 2; ++n) acc[a][b][m][n] = (f32x4){0.f, 0.f, 0.f, 0.f};
        cur = nxt; cA = nA; cB = nB; ++ui;
    }
    PG8_WAIT_V(0);
    if (wr == 0) PG8_BAR;
    PG8_BAR;
    if constexpr (Epi::AFTER_DRAIN) { E.fused(acc, cur, wr, wc, fr, fq, lds, wid, lane); S.done(cur); }
#undef PG8_SA
#undef PG8_SB
#undef PG8_STAGE
#undef PG8_LDA

#undef PG8_LDB
#undef PG8_MMA
#undef PG8_WAIT_V
#undef PG8_WAIT_L
#undef PG8_BAR
#undef PG8_SCHED
}
}
namespace att {
using bf16 = __hip_bfloat16;
constexpr int   D = 128, NW = 8, QBLK = 32, KVBLK = 64;
constexpr float SCALE = 0.088388347648318440f;
constexpr float THR = 8.f;
constexpr int SDEPTH = 2;
constexpr int LDQ = 1536, LDK = 1536, LDO = 1024;
constexpr size_t SHM_V = KVBLK * D * 2, SHM_K = KVBLK * D * 2, SHM_ATTN = 2 * SHM_V + 2 * SHM_K + NW * 64 * 4;
using u32x4  = __attribute__((ext_vector_type(4))) unsigned;

using bf16x8 = __attribute__((ext_vector_type(8))) short;
using s16x4  = __attribute__((ext_vector_type(4))) short;
using f32x16 = __attribute__((ext_vector_type(16))) float;
using f32x8  = __attribute__((ext_vector_type(8))) float;
#define KSWZ(row, colB) ((row) * 256 + ((colB) ^ (((row) & 7) << 4)))
#define SBAR() __builtin_amdgcn_sched_barrier(0)
__device__ __forceinline__ int crow(int r, int hi) { return (r & 3) + 8 * (r >> 2) + 4 * hi; }
__device__ __forceinline__ unsigned cvtpk(float lo, float hi) {
  unsigned r; asm volatile("v_cvt_pk_bf16_f32 %0, %1, %2" : "=v"(r) : "v"(lo), "v"(hi)); return r;
}
template <typename TIn> struct Stage;
template <> struct Stage<bf16>  { using T = bf16x8;
  __device__ static __forceinline__ T ld8(const bf16* p) { return *reinterpret_cast<const bf16x8*>(p); }
  __device__ static __forceinline__ bf16x8 tobf(T x) { return x; } };
template <> struct Stage<float> { using T = f32x8;
  __device__ static __forceinline__ T ld8(const float* p) { return *reinterpret_cast<const f32x8*>(p); }
  __device__ static __forceinline__ bf16x8 tobf(T x) {
    u32x4 w = {cvtpk(x[0], x[1]), cvtpk(x[2], x[3]), cvtpk(x[4], x[5]), cvtpk(x[6], x[7])}; return *reinterpret_cast<bf16x8*>(&w); } };

__device__ __forceinline__ void partialSM(f32x16& p0, f32x16& p1, float& m_reg, float& mn, float& alpha) {
  constexpr float C = SCALE * 1.4426950408889634f;
  float pmax = p0[0]; for (int r = 1; r < 16; ++r) pmax = fmaxf(pmax, p0[r]); for (int r = 0; r < 16; ++r) pmax = fmaxf(pmax, p1[r]);
  { auto rr = __builtin_amdgcn_permlane32_swap(__float_as_uint(pmax), __float_as_uint(pmax), false, false);
    pmax = fmaxf(__uint_as_float(rr[0]), __uint_as_float(rr[1])); }
  if (__builtin_expect(__all(pmax - m_reg <= THR / SCALE), 1)) { mn = m_reg; alpha = 1.f; }
  else { mn = fmaxf(m_reg, pmax); alpha = __builtin_amdgcn_exp2f((m_reg - mn) * C); m_reg = mn; }
  float mnC = -mn * C;
  for (int r = 0; r < 16; ++r) p0[r] = fmaf(p0[r], C, mnC); for (int r = 0; r < 16; ++r) p1[r] = fmaf(p1[r], C, mnC);
  for (int r = 0; r < 16; ++r) p0[r] = __builtin_amdgcn_exp2f(p0[r]);
}
__device__ __forceinline__ void finishSM(f32x16& p0, f32x16& p1, float alpha, float& l_reg, bf16x8& pa0, bf16x8& pa1, bf16x8& pa2, bf16x8& pa3) {
  for (int r = 0; r < 16; ++r) p1[r] = __builtin_amdgcn_exp2f(p1[r]);
  float ps = 0; for (int r = 0; r < 16; ++r) ps += p0[r]; for (int r = 0; r < 16; ++r) ps += p1[r];
  { auto rr = __builtin_amdgcn_permlane32_swap(__float_as_uint(ps), __float_as_uint(ps), false, false);
    ps = __uint_as_float(rr[0]) + __uint_as_float(rr[1]); }
  l_reg = l_reg * alpha + ps;
#define PK4(P, BASE, OUT) do { unsigned a0 = cvtpk(P[BASE + 0], P[BASE + 1]), a1 = cvtpk(P[BASE + 2], P[BASE + 3]);   \
    unsigned b0 = cvtpk(P[BASE + 4], P[BASE + 5]), b1 = cvtpk(P[BASE + 6], P[BASE + 7]);                              \
    auto r0 = __builtin_amdgcn_permlane32_swap(a0, b0, false, false); auto r1 = __builtin_amdgcn_permlane32_swap(a1, b1, false, false); \
    u32x4 w = {r0[0], r1[0], r0[1], r1[1]}; OUT = *reinterpret_cast<bf16x8*>(&w); } while (0)
  PK4(p0, 0, pa0); PK4(p0, 8, pa1); PK4(p1, 0, pa2); PK4(p1, 8, pa3);
#undef PK4
}
__device__ __forceinline__ void qkt(f32x16& p0, f32x16& p1, const bf16* Ks, const bf16x8* qr, int r32, int hi) {
  p0 = f32x16{}; p1 = f32x16{};
  for (int d0 = 0; d0 < 8; ++d0) { int cb = (d0 * 16 + hi * 8) * 2;
    bf16x8 b0 = *reinterpret_cast<const bf16x8*>((const char*)Ks + KSWZ(r32, cb));
    bf16x8 b1 = *reinterpret_cast<const bf16x8*>((const char*)Ks + KSWZ(32 + r32, cb));
    p0 = __builtin_amdgcn_mfma_f32_32x32x16_bf16(b0, qr[d0], p0, 0, 0, 0);
    p1 = __builtin_amdgcn_mfma_f32_32x32x16_bf16(b1, qr[d0], p1, 0, 0, 0); }
}
__device__ __forceinline__ int v_st(int k, int c) { const int kk = (k & ~0xC) | ((k & 4) << 1) | ((k & 8) >> 1); return ((kk >> 3) * 4 + (c >> 5)) * 512 + ((kk & 7) * 32 + (c & 31)) * 2; }
__device__ __forceinline__ int v_rd_base(int lane) { return ((lane & 3) << 3) | (((lane >> 2) & 3) << 6) | (((lane >> 4) & 1) << 5) | (((lane >> 5) & 1) << 8); }
constexpr int v_rd_off(int d0, int ks, int half) { return d0 * 512 + ks * 4096 + half * 2048; }
template <int OFF> __device__ __forceinline__ s16x4 tr_read(int vb) {
  s16x4 r; asm volatile("ds_read_b64_tr_b16 %0, %1 offset:%2" : "=&v"(r) : "v"(vb), "i"(OFF) : "memory"); return r;
}
template <int D0> __device__ __forceinline__ void pv_one(f32x16& od, int vb, bf16x8 pa0, bf16x8 pa1, bf16x8 pa2, bf16x8 pa3) {
  const s16x4 l0 = tr_read<v_rd_off(D0, 0, 0)>(vb), h0 = tr_read<v_rd_off(D0, 0, 1)>(vb), l1 = tr_read<v_rd_off(D0, 1, 0)>(vb), h1 = tr_read<v_rd_off(D0, 1, 1)>(vb);
  const s16x4 l2 = tr_read<v_rd_off(D0, 2, 0)>(vb), h2 = tr_read<v_rd_off(D0, 2, 1)>(vb), l3 = tr_read<v_rd_off(D0, 3, 0)>(vb), h3 = tr_read<v_rd_off(D0, 3, 1)>(vb);
  asm volatile("s_waitcnt lgkmcnt(0)" ::: "memory"); SBAR();
#define PK(L, H) (bf16x8){L[0], L[1], L[2], L[3], H[0], H[1], H[2], H[3]}
  od = __builtin_amdgcn_mfma_f32_32x32x16_bf16(pa0, PK(l0, h0), od, 0, 0, 0);
  od = __builtin_amdgcn_mfma_f32_32x32x16_bf16(pa1, PK(l1, h1), od, 0, 0, 0);
  od = __builtin_amdgcn_mfma_f32_32x32x16_bf16(pa2, PK(l2, h2), od, 0, 0, 0);
  od = __builtin_amdgcn_mfma_f32_32x32x16_bf16(pa3, PK(l3, h3), od, 0, 0, 0);
#undef PK
}
__device__ __forceinline__ void pv_d0(f32x16* o, int vb, bf16x8 pa0, bf16x8 pa1, bf16x8 pa2, bf16x8 pa3) {
  pv_one<0>(o[0], vb, pa0, pa1, pa2, pa3); pv_one<1>(o[1], vb, pa0, pa1, pa2, pa3); pv_one<2>(o[2], vb, pa0, pa1, pa2, pa3); pv_one<3>(o[3], vb, pa0, pa1, pa2, pa3);
}

template <typename TQ>
__device__ __forceinline__ void attn_dense_body(const TQ* __restrict__ Qb, const bf16* __restrict__ Kh, const bf16* __restrict__ Vh,
                                                bf16* __restrict__ Ob, int seq, char* lds) {
  using St = Stage<bf16>; using SQ = Stage<TQ>;
  int tid_ = threadIdx.x; asm volatile("" : "+v"(tid_)); const int tid = tid_, wid = tid >> 6, lane = tid & 63, r32 = lane & 31, hi = lane >> 5;
  bf16* V_lds = (bf16*)lds; bf16* K_lds = (bf16*)(lds + 2 * SHM_V);
  float* ws = (float*)(lds + 2 * SHM_V + 2 * SHM_K) + wid * 64; float* li_l = ws; float* al_l = ws + 32;
  float m_reg = -1e30f, l_reg = 0; f32x16 o[4] = {}; bf16x8 qr[8];
  const TQ* Qw = Qb + (long)(wid * QBLK + r32) * LDQ + hi * 8;
#pragma unroll
  for (int d0 = 0; d0 < 8; ++d0) qr[d0] = SQ::tobf(SQ::ld8(Qw + d0 * 16));
  const int sr = tid >> 4, sc = (tid & 15) * 8, vst0 = v_st(sr, sc), vst1 = v_st(32 + sr, sc);
  const int vb0 = (int)(uintptr_t)V_lds + v_rd_base(lane);
  struct { typename St::T vs0, vs1, ks0, ks1; } sr_[SDEPTH];
#define SLOAD(i, k0) do { sr_[i].vs0 = St::ld8(&Vh[(long)((k0) + sr) * LDK + sc]); sr_[i].vs1 = St::ld8(&Vh[(long)((k0) + 32 + sr) * LDK + sc]); \
    sr_[i].ks0 = St::ld8(&Kh[(long)((k0) + sr) * LDK + sc]); sr_[i].ks1 = St::ld8(&Kh[(long)((k0) + 32 + sr) * LDK + sc]); } while (0)
#define SWRITE(b, i) do { *(bf16x8*)((char*)V_lds + (b) * SHM_V + vst0) = St::tobf(sr_[i].vs0);          \
    *(bf16x8*)((char*)V_lds + (b) * SHM_V + vst1) = St::tobf(sr_[i].vs1); int kc = sc * 2;               \
    *(bf16x8*)((char*)K_lds + (b) * SHM_K + KSWZ(sr, kc)) = St::tobf(sr_[i].ks0);                       \
    *(bf16x8*)((char*)K_lds + (b) * SHM_K + KSWZ(32 + sr, kc)) = St::tobf(sr_[i].ks1); } while (0)
#define SWAIT() do { if constexpr (SDEPTH == 2) asm volatile("s_waitcnt vmcnt(4)" ::: "memory"); else asm volatile("s_waitcnt vmcnt(0)" ::: "memory"); } while (0)
#define RESC(a) do { if (__any((a) < 1.f)) { if (hi == 0) al_l[r32] = (a); asm volatile("s_waitcnt lgkmcnt(0)" ::: "memory"); \
    for (int d = 0; d < 4; ++d) for (int r = 0; r < 16; ++r) o[d][r] *= al_l[crow(r, hi)]; } } while (0)
  f32x16 pA0, pA1, pB0, pB1; float mnA, mnB, alA, alB; bf16x8 pa0, pa1, pa2, pa3; const int NT = seq / KVBLK;
  constexpr int SE = 0, SO = SDEPTH - 1;
  SLOAD(SE, 0); asm volatile("s_waitcnt vmcnt(0)" ::: "memory"); SWRITE(0, SE); __syncthreads();
  qkt(pA0, pA1, K_lds, qr, r32, hi); partialSM(pA0, pA1, m_reg, mnA, alA);
  SLOAD(SO, KVBLK); if constexpr (SDEPTH == 2) { if (2 < NT) SLOAD(SE, 2 * KVBLK); }
  SWAIT(); SWRITE(1, SO); __syncthreads();
  for (int j = 1; j + 1 < NT; j += 2) {
    SBAR(); qkt(pB0, pB1, (bf16*)((char*)K_lds + SHM_K), qr, r32, hi);
    finishSM(pA0, pA1, alA, l_reg, pa0, pa1, pa2, pa3); SBAR();
    SLOAD(SO, (j + SDEPTH) * KVBLK); SBAR();
    pv_d0(o, vb0, pa0, pa1, pa2, pa3); partialSM(pB0, pB1, m_reg, mnB, alB);
    __syncthreads(); SWAIT(); SWRITE(0, SE);
    RESC(alB); __syncthreads();
    SBAR(); qkt(pA0, pA1, K_lds, qr, r32, hi);
    finishSM(pB0, pB1, alB, l_reg, pa0, pa1, pa2, pa3); SBAR();
    if (SDEPTH == 1 || j + 3 < NT) SLOAD(SE, (j + 1 + SDEPTH) * KVBLK); SBAR();
    pv_d0(o, vb0 + (int)SHM_V, pa0, pa1, pa2, pa3); partialSM(pA0, pA1, m_reg, mnA, alA);
    __syncthreads(); SWAIT(); SWRITE(1, SO);
    RESC(alA); __syncthreads();
  }
  SBAR(); qkt(pB0, pB1, (bf16*)((char*)K_lds + SHM_K), qr, r32, hi);
  finishSM(pA0, pA1, alA, l_reg, pa0, pa1, pa2, pa3); SBAR();
  pv_d0(o, vb0, pa0, pa1, pa2, pa3); partialSM(pB0, pB1, m_reg, mnB, alB);
  __syncthreads(); RESC(alB);
  finishSM(pB0, pB1, alB, l_reg, pa0, pa1, pa2, pa3); SBAR();
  pv_d0(o, vb0 + (int)SHM_V, pa0, pa1, pa2, pa3);
  if (hi == 0) li_l[r32] = l_reg; asm volatile("s_waitcnt lgkmcnt(0)" ::: "memory");
  float rli[16];
#pragma unroll
  for (int r = 0; r < 16; ++r) rli[r] = __builtin_amdgcn_rcpf(li_l[crow(r, hi)]);
  bf16* Ow = Ob + (long)(wid * QBLK) * LDO;
#pragma unroll
  for (int r = 0; r < 16; ++r) { int orow = crow(r, hi);
#pragma unroll
    for (int d0 = 0; d0 < 4; ++d0) Ow[(long)orow * LDO + d0 * 32 + r32] = __float2bfloat16(o[d0][r] * rli[r]); }
#undef SLOAD
#undef SWRITE
#undef SWAIT
#undef RESC
}

#undef KSWZ
}

#define LAS __attribute__((address_space(3)))
typedef unsigned short bf16_t;
typedef float f32x2 __attribute__((ext_vector_type(2)));
typedef float f32x4 __attribute__((ext_vector_type(4)));
typedef unsigned u32x4 __attribute__((ext_vector_type(4)));
typedef unsigned u32x2 __attribute__((ext_vector_type(2)));

struct Params { const float* in[24]; float* out; unsigned char* ws; };
typedef const __attribute__((address_space(4))) Params* ParamsPtr;
#if defined(__HIP_DEVICE_COMPILE__)
__device__ __forceinline__ Params get_params() { ParamsPtr q = (ParamsPtr)__builtin_amdgcn_kernarg_segment_ptr(); asm volatile("" : "+s"(q)); return *q; }
#else
__device__ __forceinline__ Params get_params() { return Params{}; }
#endif
__device__ __forceinline__ int lv(int x) { asm volatile("" : "+v"(x)); return x; }
__device__ __forceinline__ int ls(int x) { asm volatile("" : "+s"(x)); return x; }
#define TID() lv((int)threadIdx.x)
#define BID() ls((int)blockIdx.x)
#define NBLK() ls((int)gridDim.x)

constexpr size_t SZ_WIN = (size_t)NIN * DM * 2, SZ_WHY = (size_t)DM * HYW * 2, SZ_WAT = (size_t)DM * QW * 2, SZ_WO = (size_t)DM * DM * 2, SZ_WUP = (size_t)DFF * DM * 2, SZ_WDN = (size_t)DM * DFF * 2;
constexpr size_t WS_WIN = 0, WS_WHY = WS_WIN + SZ_WIN, WS_WAT = WS_WHY + SZ_WHY, WS_WO = WS_WAT + SZ_WAT, WS_WUP = WS_WO + SZ_WO, WS_WDN = WS_WUP + SZ_WUP;
constexpr size_t WS_HB = WS_WDN + SZ_WDN;
constexpr size_t WS_YHY = WS_HB, WS_YAT = WS_HB + (size_t)NTOK * HYW * 2;
constexpr size_t WS_X = WS_HB + (size_t)NTOK * DM * 2;
constexpr size_t WS_PH = WS_X, WS_QKV = WS_PH + (size_t)NTOK * 3072 * 2, WS_G = WS_QKV + (size_t)NTOK * 1536 * 2;
constexpr size_t WS_FF = WS_X, WS_MRG = WS_X, WS_KS = WS_X;
constexpr size_t WS_R = WS_X + (size_t)NTOK * NIN * 2;
constexpr size_t WS_Z = WS_R, WS_X0T = WS_R + (size_t)HYW * NTOK * 4, WS_DLT = WS_R;
constexpr size_t WS_HDN = WS_X0T + (size_t)HYW * NTOK * 2;
constexpr size_t WS_END = WS_HDN + (size_t)DEPTH * SEQL * FHID * 4;

constexpr int FFTN = 16384, FFT_LDS = (FFTN + FFTN / 16) * 8;
constexpr int LDS_BYTES = FFT_LDS + 1024;

__device__ __forceinline__ float bf_lo(unsigned w) { return __uint_as_float(w << 16); }
__device__ __forceinline__ float bf_hi(unsigned w) { return __uint_as_float(w & 0xffff0000u); }
__device__ __forceinline__ unsigned pk_bf16(float lo, float hi) { return pg8::cvt_pk_bf16(lo, hi); }

template <int MODE> struct EpiX {
    static constexpr bool PERM = true, AFTER_DRAIN = false;
    bf16_t* O; int ldc; bf16_t* O2; bf16_t* O3; const bf16_t* G; int gofs;
    __device__ __forceinline__ void operator()(const pg8::f32x4 (&acc)[2][2][4][2], const pg8::Unit& u, int wr, int wc, int fr, int fq) const {
        const int row0 = u.pm * 256 + wr * 64 + fr; int colt = u.pn * 256; bf16_t* base = O; int ld = ldc; bool sig = false;
        if (MODE == 0) { if (u.pn >= 18) { base = O3; ld = 4096; colt -= 4608; sig = true; } else if (u.pn >= 12) { base = O2; ld = 1536; colt -= 3072; } }
        const int col0 = colt + wc * 32 + 8 * fq;
#pragma unroll
        for (int ai = 0; ai < 2; ++ai)
#pragma unroll
            for (int m = 0; m < 4; ++m) {
                const size_t r = (size_t)(row0 + ai * 128 + m * 16);
                bf16_t* rowp = base + r * ld + col0;
#pragma unroll
                for (int bj = 0; bj < 2; ++bj) {
                    pg8::f32x4 v0 = acc[ai][bj][m][0], v1 = acc[ai][bj][m][1];
                    if (MODE == 0) { if (sig) {
#pragma unroll
                        for (int j = 0; j < 4; ++j) { v0[j] = __builtin_amdgcn_rcpf(1.0f + __expf(-v0[j])); v1[j] = __builtin_amdgcn_rcpf(1.0f + __expf(-v1[j])); } } }
                    if (MODE == 1 || MODE == 2) {
                        const u32x4 gw = *(const u32x4*)(G + r * 4096 + gofs + col0 + bj * 128);
                        v0[0] *= bf_lo(gw.x); v0[1] *= bf_hi(gw.x); v0[2] *= bf_lo(gw.y); v0[3] *= bf_hi(gw.y);
                        v1[0] *= bf_lo(gw.z); v1[1] *= bf_hi(gw.z); v1[2] *= bf_lo(gw.w); v1[3] *= bf_hi(gw.w); }
                    if (MODE == 2) {
                        const u32x4 ow = *(const u32x4*)(rowp + bj * 128);
                        v0[0] += bf_lo(ow.x); v0[1] += bf_hi(ow.x); v0[2] += bf_lo(ow.y); v0[3] += bf_hi(ow.y);
                        v1[0] += bf_lo(ow.z); v1[1] += bf_hi(ow.z); v1[2] += bf_lo(ow.w); v1[3] += bf_hi(ow.w); }
                    if (MODE == 4) {
#pragma unroll
                        for (int j = 0; j < 4; ++j) { const float a = fmaxf(v0[j], 0.f), b = fmaxf(v1[j], 0.f); v0[j] = a * a; v1[j] = b * b; } }
                    u32x4 w; w.x = pk_bf16(v0[0], v0[1]); w.y = pk_bf16(v0[2], v0[3]); w.z = pk_bf16(v1[0], v1[1]); w.w = pk_bf16(v1[2], v1[3]);
                    *(u32x4*)(rowp + bj * 128) = w; } }
    }
};

template <int MODE>
__device__ __forceinline__ void run_gemm(unsigned char* lds, const bf16_t* A, const bf16_t* Bt, int N, int K, const EpiX<MODE>& E) {
    pg8::Gemm g{A, Bt, NTOK, N, K}; pg8::StaticOrder S; S.init(NTOK, N, NBLK(), BID());
    pg8::gemm_phase<EpiX<MODE>, pg8::StaticOrder>((PG8_LAS unsigned char*)lds, g, S, E);
}

__device__ __forceinline__ void convert_tile(const float* __restrict__ src, int K, int N, bf16_t* __restrict__ dst, int tk, int tn, LAS float* tile, int tid) {
    { const int kk = tid >> 3, n8 = (tid & 7) * 8; const float* s = src + (size_t)(tk * 64 + kk) * N + tn * 64 + n8;
      const f32x4 a = *(const f32x4*)s, b = *(const f32x4*)(s + 4);
      LAS float* d = tile + kk * 65 + n8; d[0] = a[0]; d[1] = a[1]; d[2] = a[2]; d[3] = a[3]; d[4] = b[0]; d[5] = b[1]; d[6] = b[2]; d[7] = b[3]; }
    __syncthreads();
    { const int n = tid >> 3, k8 = (tid & 7) * 8; float v[8];
#pragma unroll
      for (int e = 0; e < 8; ++e) v[e] = tile[(k8 + e) * 65 + n];
      u32x4 w; w.x = pk_bf16(v[0], v[1]); w.y = pk_bf16(v[2], v[3]); w.z = pk_bf16(v[4], v[5]); w.w = pk_bf16(v[6], v[7]);
      *(u32x4*)(dst + (size_t)(tn * 64 + n) * K + tk * 64 + k8) = w; }
    __syncthreads();
}
__device__ __forceinline__ void convert_weights_phase(int layer, unsigned char* lds) {
    const Params p = get_params(); const int bid = BID(), nblk = NBLK();
    LAS float* tile = (LAS float*)lds; const int tid = TID(); unsigned char* ws = p.ws;
    for (int id = bid; id < 14592; id += nblk) {
        const float* src; bf16_t* dst; int K, N, loc;
        if (id < 4352)       { loc = id;         K = DM;  N = NIN; src = p.in[3]  + (size_t)layer * DM * NIN;  dst = (bf16_t*)(ws + WS_WIN); }
        else if (id < 4864)  { loc = id - 4352;  K = HYW; N = DM;  src = p.in[15] + (size_t)layer * HYW * DM;  dst = (bf16_t*)(ws + WS_WHY); }
        else if (id < 5376)  { loc = id - 4864;  K = QW;  N = DM;  src = p.in[16] + (size_t)layer * QW * DM;   dst = (bf16_t*)(ws + WS_WAT); }
        else if (id < 6400)  { loc = id - 5376;  K = DM;  N = DM;  src = p.in[17] + (size_t)layer * DM * DM;   dst = (bf16_t*)(ws + WS_WO); }
        else if (id < 10496) { loc = id - 6400;  K = DM;  N = DFF; src = p.in[20] + (size_t)layer * DM * DFF;  dst = (bf16_t*)(ws + WS_WUP); }
        else                 { loc = id - 10496; K = DFF; N = DM;  src = p.in[21] + (size_t)layer * DFF * DM;  dst = (bf16_t*)(ws + WS_WDN); }
        const int ntn = N >> 6, tk = loc / ntn, tn = loc - tk * ntn;
        convert_tile(src, K, N, dst, tk, tn, tile, tid);
    }
}

template <int MODE>
__device__ __forceinline__ void ln_phase(int gi, int bi, int layer) {
    const Params p = get_params(); const int bid = BID(), nblk = NBLK();
    const float* src = p.in[0]; const bf16_t* delta = (const bf16_t*)(p.ws + WS_DLT); const float* g = p.in[gi] + layer * DM; const float* b = p.in[bi] + layer * DM; float* hio = p.out; bf16_t* hb = (bf16_t*)(p.ws + WS_HB);
    const int tid = TID(), wid = tid >> 6, lane = tid & 63;
    for (int row = bid * 8 + wid; row < NTOK; row += nblk * 8) {
        f32x4 v[8];
        const float* s = (MODE == 0 ? src : hio) + (size_t)row * DM;
#pragma unroll
        for (int k = 0; k < 8; ++k) v[k] = *(const f32x4*)(s + (k * 64 + lane) * 4);
        if (MODE == 1) {
#pragma unroll
            for (int k = 0; k < 8; ++k) { const u32x2 d = *(const u32x2*)(delta + (size_t)row * DM + (k * 64 + lane) * 4);
                v[k][0] = ALPHA_F * v[k][0] + bf_lo(d.x); v[k][1] = ALPHA_F * v[k][1] + bf_hi(d.x); v[k][2] = ALPHA_F * v[k][2] + bf_lo(d.y); v[k][3] = ALPHA_F * v[k][3] + bf_hi(d.y); } }
        float sum = 0.f;
#pragma unroll
        for (int k = 0; k < 8; ++k) sum += (v[k][0] + v[k][1]) + (v[k][2] + v[k][3]);
#pragma unroll
        for (int o = 32; o > 0; o >>= 1) sum += __shfl_xor(sum, o);
        const float mean = sum * (1.0f / DM);
        float q = 0.f;
#pragma unroll
        for (int k = 0; k < 8; ++k) { const f32x4 d = v[k] - mean; q += (d[0] * d[0] + d[1] * d[1]) + (d[2] * d[2] + d[3] * d[3]); }
#pragma unroll
        for (int o = 32; o > 0; o >>= 1) q += __shfl_xor(q, o);
        const float rstd = rsqrtf(q * (1.0f / DM) + LN_EPS);
#pragma unroll
        for (int k = 0; k < 8; ++k) { const int c = (k * 64 + lane) * 4; const f32x4 gg = *(const f32x4*)(g + c), bb = *(const f32x4*)(b + c);
            const f32x4 o = (v[k] - mean) * rstd * gg + bb;
            *(f32x4*)(hio + (size_t)row * DM + c) = o;
            u32x2 w; w.x = pk_bf16(o[0], o[1]); w.y = pk_bf16(o[2], o[3]); *(u32x2*)(hb + (size_t)row * DM + c) = w; }
    }
}

__device__ __forceinline__ void hdn_phase(unsigned char* lds) {
    const Params p = get_params(); const int bid = BID(), nblk = NBLK();
    LAS float* feats = (LAS float*)lds;
    LAS float* h1 = feats + 8 * 33;
    const int tid = TID(); float* HDN = (float*)(p.ws + WS_HDN);
    for (int it = bid; it < DEPTH * (SEQL / 8); it += nblk) {
        const int layer = it / (SEQL / 8), t0 = (it - layer * (SEQL / 8)) * 8;
        const float* w1 = p.in[6] + layer * FEMB * FHID; const float* b1 = p.in[7] + layer * FHID;
        const float* w2 = p.in[8] + layer * FHID * FHID; const float* b2 = p.in[9] + layer * FHID; const float* fr = p.in[11] + layer * FHID;
        if (tid < 8 * 33) { const int tt = tid / 33, i = tid - tt * 33; const int pos = t0 + tt; float f;
            if (i == 0) f = (float)pos / (float)(SEQL - 1);
            else { const int bnd = (i - 1) & 15; const float wv = 6.283185307179586f * (float)pos / (float)SEQL; const float fb = 1e-4f + (float)bnd * ((15.0f - 1e-4f) / 15.0f);
                   const float ang = wv * fb; f = (i <= 16) ? cosf(ang) : -sinf(ang); }
            feats[tid] = f; }
        __syncthreads();
        const int tt = tid >> 6, j = tid & 63;
        { float a = b1[j];
#pragma unroll
          for (int i = 0; i < FEMB; ++i) a += feats[tt * 33 + i] * w1[i * FHID + j];
          h1[tt * 64 + j] = sinf(fr[j] * a); }
        __syncthreads();
        { float a = b2[j];
#pragma unroll 8
          for (int i = 0; i < FHID; ++i) a += h1[tt * 64 + i] * w2[i * FHID + j];
          HDN[((size_t)layer * SEQL + t0 + tt) * FHID + j] = sinf(fr[j] * a); }
        __syncthreads();
    }
}

__device__ __forceinline__ void hyena_pre_phase(int layer, unsigned char* lds) {
    const Params p = get_params(); const int bid = BID(), nblk = NBLK();
    LAS float* zs = (LAS float*)lds; LAS float* xs = zs + 64 * 65;
    const int tid = TID();
    const bf16_t* PH = (const bf16_t*)(p.ws + WS_PH); float* Z = (float*)(p.ws + WS_Z); bf16_t* X0T = (bf16_t*)(p.ws + WS_X0T);
    const float* cw = p.in[4] + (size_t)layer * 3 * 3072; const float* cb = p.in[5] + (size_t)layer * 3072;
    for (int tile = bid; tile < 4096; tile += nblk) {
        const int t0 = (tile >> 4) * 64, c0 = (tile & 15) * 64;
        const int tt = tid >> 3, cg8 = (tid & 7) * 8, t = t0 + tt, tl = t & (SEQL - 1);
        float o[3][8];
#pragma unroll
        for (int g = 0; g < 3; ++g) {
            const int ch = g * 1024 + c0 + cg8;
            const bf16_t* pr = PH + (size_t)t * 3072 + ch;
            const u32x4 z4 = {0u, 0u, 0u, 0u};
            const u32x4 xm = tl > 0 ? *(const u32x4*)(pr - 3072) : z4;
            const u32x4 xc = *(const u32x4*)pr;
            const u32x4 xp = tl < SEQL - 1 ? *(const u32x4*)(pr + 3072) : z4;
            const f32x4 w0a = *(const f32x4*)(cw + ch), w0b = *(const f32x4*)(cw + ch + 4);
            const f32x4 w1a = *(const f32x4*)(cw + 3072 + ch), w1b = *(const f32x4*)(cw + 3072 + ch + 4);
            const f32x4 w2a = *(const f32x4*)(cw + 6144 + ch), w2b = *(const f32x4*)(cw + 6144 + ch + 4);
            const f32x4 ba = *(const f32x4*)(cb + ch), bb = *(const f32x4*)(cb + ch + 4);
            o[g][0] = bf_lo(xm.x) * w0a[0] + bf_lo(xc.x) * w1a[0] + bf_lo(xp.x) * w2a[0] + ba[0];
            o[g][1] = bf_hi(xm.x) * w0a[1] + bf_hi(xc.x) * w1a[1] + bf_hi(xp.x) * w2a[1] + ba[1];
            o[g][2] = bf_lo(xm.y) * w0a[2] + bf_lo(xc.y) * w1a[2] + bf_lo(xp.y) * w2a[2] + ba[2];
            o[g][3] = bf_hi(xm.y) * w0a[3] + bf_hi(xc.y) * w1a[3] + bf_hi(xp.y) * w2a[3] + ba[3];
            o[g][4] = bf_lo(xm.z) * w0b[0] + bf_lo(xc.z) * w1b[0] + bf_lo(xp.z) * w2b[0] + bb[0];
            o[g][5] = bf_hi(xm.z) * w0b[1] + bf_hi(xc.z) * w1b[1] + bf_hi(xp.z) * w2b[1] + bb[1];
            o[g][6] = bf_lo(xm.w) * w0b[2] + bf_lo(xc.w) * w1b[2] + bf_lo(xp.w) * w2b[2] + bb[2];
            o[g][7] = bf_hi(xm.w) * w0b[3] + bf_hi(xc.w) * w1b[3] + bf_hi(xp.w) * w2b[3] + bb[3];
        }
        __syncthreads();
#pragma unroll
        for (int e = 0; e < 8; ++e) { zs[(cg8 + e) * 65 + tt] = o[2][e] * o[1][e]; xs[(cg8 + e) * 65 + tt] = o[0][e]; }
        __syncthreads();
        { const int c = tid >> 3, tq = (tid & 7) * 8; const int bidx = t0 >> 13, tl0 = t0 & (SEQL - 1);
          float zv[8], xv[8];
#pragma unroll
          for (int e = 0; e < 8; ++e) { zv[e] = zs[c * 65 + tq + e]; xv[e] = xs[c * 65 + tq + e]; }
          const size_t off = ((size_t)(c0 + c) * 2 + bidx) * SEQL + tl0 + tq;
          *(f32x4*)(Z + off) = (f32x4){zv[0], zv[1], zv[2], zv[3]}; *(f32x4*)(Z + off + 4) = (f32x4){zv[4], zv[5], zv[6], zv[7]};
          u32x4 w; w.x = pk_bf16(xv[0], xv[1]); w.y = pk_bf16(xv[2], xv[3]); w.z = pk_bf16(xv[4], xv[5]); w.w = pk_bf16(xv[6], xv[7]);
          *(u32x4*)(X0T + off) = w; }
    }
}

__device__ __forceinline__ void qk_rope_phase(int layer) {
    const Params p = get_params(); const int bid = BID(), nblk = NBLK();
    const int tid = TID(), sub = tid & 15;
    bf16_t* QKV = (bf16_t*)(p.ws + WS_QKV);
    const float* qn = p.in[13] + layer * HD; const float* kn = p.in[14] + layer * HD;
    for (int vi = bid * 32 + (tid >> 4); vi < NTOK * 10; vi += nblk * 32) {
        const int t = vi / 10, hh = vi - t * 10, tl = t & (SEQL - 1);
        bf16_t* ptr = QKV + (size_t)t * 1536 + hh * HD + sub * 8;
        const u32x4 w = *(const u32x4*)ptr;
        float x[8] = {bf_lo(w.x), bf_hi(w.x), bf_lo(w.y), bf_hi(w.y), bf_lo(w.z), bf_hi(w.z), bf_lo(w.w), bf_hi(w.w)};
        float ss = 0.f;
#pragma unroll
        for (int e = 0; e < 8; ++e) ss += x[e] * x[e];
        ss += __shfl_xor(ss, 1); ss += __shfl_xor(ss, 2); ss += __shfl_xor(ss, 4); ss += __shfl_xor(ss, 8);
        const float rs = rsqrtf(ss * (1.0f / HD) + RMS_EPS);
        const float* gp = (hh < 8 ? qn : kn) + sub * 8;
        const f32x4 ga = *(const f32x4*)gp, gb = *(const f32x4*)(gp + 4);
        x[0] *= rs * ga[0]; x[1] *= rs * ga[1]; x[2] *= rs * ga[2]; x[3] *= rs * ga[3]; x[4] *= rs * gb[0]; x[5] *= rs * gb[1]; x[6] *= rs * gb[2]; x[7] *= rs * gb[3];
        const float pos = (float)((sub >> 3) == 0 ? (tl >> 6) : (tl & 63));
        const bool hi_half = ((sub >> 2) & 1) != 0;
        float y[8];
#pragma unroll
        for (int e = 0; e < 8; ++e) {
            const int i = (sub & 3) * 8 + e;
            const float inv = exp2f(-(float)i * (13.287712379549449f / 32.0f));
            float sn, cs; sincosf(pos * inv, &sn, &cs);
            const float other = __shfl_xor(x[e], 4);
            y[e] = hi_half ? (x[e] * cs + other * sn) : (x[e] * cs - other * sn);
        }
        u32x4 o; o.x = pk_bf16(y[0], y[1]); o.y = pk_bf16(y[2], y[3]); o.z = pk_bf16(y[4], y[5]); o.w = pk_bf16(y[6], y[7]);
        *(u32x4*)ptr = o;
    }
}

__device__ __forceinline__ int fpad(int i) { return i + (i >> 4); }
__device__ __forceinline__ f32x2 cmul(f32x2 a, f32x2 b) { return (f32x2){a.x * b.x - a.y * b.y, a.x * b.y + a.y * b.x}; }
__device__ __forceinline__ constexpr float c16(int k) { return k == 0 ? 1.0f : k == 1 ? 0.9238795325112867f : k == 2 ? 0.7071067811865476f : k == 3 ? 0.3826834323650898f : k == 4 ? 0.0f : k == 5 ? -0.3826834323650898f : k == 6 ? -0.7071067811865476f : -0.9238795325112867f; }
__device__ __forceinline__ constexpr float s16(int k) { return k == 0 ? 0.0f : k == 1 ? 0.3826834323650898f : k == 2 ? 0.7071067811865476f : k == 3 ? 0.9238795325112867f : k == 4 ? 1.0f : k == 5 ? 0.9238795325112867f : k == 6 ? 0.7071067811865476f : 0.3826834323650898f; }

template <int LOGR, int SLOG, bool INV>
__device__ __forceinline__ void fft_pass(LAS f32x2* X, int tid) {
    constexpr int R = 1 << LOGR, STRIDE = 1 << SLOG, NIT = FFTN / R;
#pragma unroll 1
    for (int w = tid; w < NIT; w += NTHR) {
        const int r = w & (STRIDE - 1), i0 = ((w >> SLOG) << (SLOG + LOGR)) + r;
        f32x2 v[R];
#pragma unroll
        for (int j = 0; j < R; ++j) v[j] = X[fpad(i0 + j * STRIDE)];
        f32x2 wp[LOGR];
        if (SLOG == 0) {
#pragma unroll
            for (int s = 0; s < LOGR; ++s) wp[s] = (f32x2){1.0f, 0.0f};
        } else {
            float sn, cs; sincospif((INV ? 2.0f : -2.0f) * (float)r * (1.0f / (float)(STRIDE * R)), &sn, &cs); wp[0] = (f32x2){cs, sn};
#pragma unroll
            for (int s = 1; s < LOGR; ++s) wp[s] = cmul(wp[s - 1], wp[s - 1]);
        }
        if (!INV) {
#pragma unroll
            for (int s = 0; s < LOGR; ++s) {
                const int half = R >> (s + 1);
#pragma unroll
                for (int j = 0; j < R; ++j) if ((j & half) == 0) {
                    const int jl = j & (half - 1), idx = jl * (8 / half);
                    const f32x2 a = v[j], b = v[j + half]; v[j] = a + b; const f32x2 d = a - b;
                    if (SLOG == 0) { v[j + half] = idx == 0 ? d : cmul(d, (f32x2){c16(idx), -s16(idx)}); }
                    else { const f32x2 tw = idx == 0 ? wp[s] : cmul(wp[s], (f32x2){c16(idx), -s16(idx)}); v[j + half] = cmul(d, tw); } }
            }
        } else {
#pragma unroll
            for (int s = LOGR - 1; s >= 0; --s) {
                const int half = R >> (s + 1);
#pragma unroll
                for (int j = 0; j < R; ++j) if ((j & half) == 0) {
                    const int jl = j & (half - 1), idx = jl * (8 / half);
                    f32x2 b;
                    if (SLOG == 0) { b = idx == 0 ? v[j + half] : cmul(v[j + half], (f32x2){c16(idx), s16(idx)}); }
                    else { const f32x2 tw = idx == 0 ? wp[s] : cmul(wp[s], (f32x2){c16(idx), s16(idx)}); b = cmul(v[j + half], tw); }
                    const f32x2 a = v[j]; v[j] = a + b; v[j + half] = a - b; }
            }
        }
#pragma unroll
        for (int j = 0; j < R; ++j) X[fpad(i0 + j * STRIDE)] = v[j];
    }
}
__device__ __forceinline__ void fft_fwd(LAS f32x2* X, int tid) {
    fft_pass<4, 10, false>(X, tid); __syncthreads(); fft_pass<3, 7, false>(X, tid); __syncthreads(); fft_pass<3, 4, false>(X, tid); __syncthreads(); fft_pass<4, 0, false>(X, tid); __syncthreads();
}
__device__ __forceinline__ void fft_inv(LAS f32x2* X, int tid) {
    fft_pass<4, 0, true>(X, tid); __syncthreads(); fft_pass<3, 4, true>(X, tid); __syncthreads(); fft_pass<3, 7, true>(X, tid); __syncthreads(); fft_pass<4, 10, true>(X, tid); __syncthreads();
}

__device__ __forceinline__ void fft_conv_phase(int layer, unsigned char* lds) {
    const Params p = get_params(); const int bid = BID(), nblk = NBLK();
    LAS f32x2* X = (LAS f32x2*)lds; LAS float* W3 = (LAS float*)(lds + FFT_LDS); LAS float* RED = W3 + 128;
    const int tid = TID(), wid = tid >> 6, lane = tid & 63;
    const float* hdn = (const float*)(p.ws + WS_HDN) + (size_t)layer * SEQL * FHID;
    const float* w3 = p.in[10] + (size_t)layer * FHID * 2 * HYW; const float* skip = p.in[12] + layer * HYW;
    const float* Z = (const float*)(p.ws + WS_Z); const bf16_t* X0T = (const bf16_t*)(p.ws + WS_X0T); bf16_t* YHY = (bf16_t*)(p.ws + WS_YHY);
    f32x2* KS = (f32x2*)(p.ws + WS_KS) + (size_t)bid * FFTN;
    for (int c = bid; c < HYW; c += nblk) {
        __syncthreads();
        if (tid < 128) W3[tid] = w3[(size_t)(tid & 63) * (2 * HYW) + (tid >> 6) * HYW + c];
        __syncthreads();
        const float dl = fabsf(-15.350567286626973f + (float)c * ((-3.0701134573253946f + 15.350567286626973f) / 1023.0f));
        float asum = 0.f;
        for (int t = tid; t < SEQL; t += NTHR) {
            const f32x4* hr = (const f32x4*)(hdn + (size_t)t * FHID);
            float a0 = 0.f, a1 = 0.f;
#pragma unroll
            for (int q = 0; q < 16; ++q) { const f32x4 h = hr[q];
                a0 += h[0] * W3[4 * q] + h[1] * W3[4 * q + 1] + h[2] * W3[4 * q + 2] + h[3] * W3[4 * q + 3];
                a1 += h[0] * W3[64 + 4 * q] + h[1] * W3[64 + 4 * q + 1] + h[2] * W3[64 + 4 * q + 2] + h[3] * W3[64 + 4 * q + 3]; }
            const float dec = expf(-((float)t / (float)(SEQL - 1)) * dl);
            a0 *= dec; a1 *= dec; asum += fabsf(a0) + fabsf(a1);
            X[fpad(t)] = (f32x2){a0, 0.f}; X[fpad(2 * SEQL - 1 - t)] = (f32x2){a1, 0.f};
        }
#pragma unroll
        for (int o = 32; o > 0; o >>= 1) asum += __shfl_xor(asum, o);
        if (lane == 0) RED[wid] = asum;
        __syncthreads();
        float total = 0.f;
#pragma unroll
        for (int i = 0; i < 8; ++i) total += RED[i];
        fft_fwd(X, tid);
        for (int i = tid; i < FFTN; i += NTHR) KS[i] = X[fpad(i)];
        __syncthreads();
        const float* z0 = Z + (size_t)c * 2 * SEQL; const float* z1 = z0 + SEQL;
        for (int t = tid; t < SEQL; t += NTHR) { X[fpad(t)] = (f32x2){z0[t], z1[t]}; X[fpad(SEQL + t)] = (f32x2){0.f, 0.f}; }
        __syncthreads();
        fft_fwd(X, tid);
        const float scale = 1.0f / ((float)FFTN * total);
        for (int i = tid; i < FFTN; i += NTHR) { const f32x2 kk = KS[i]; X[fpad(i)] = cmul(X[fpad(i)], kk) * scale; }
        __syncthreads();
        fft_inv(X, tid);
        const float sk = skip[c];
        const bf16_t* x00 = X0T + (size_t)c * 2 * SEQL; const bf16_t* x01 = x00 + SEQL;
        for (int t = tid; t < SEQL; t += NTHR) {
            const f32x2 y = X[fpad(t)];
            const float xa = __uint_as_float((unsigned)x00[t] << 16), xb = __uint_as_float((unsigned)x01[t] << 16);
            const float ya = xa * (y.x + sk * z0[t]), yb = xb * (y.y + sk * z1[t]);
            YHY[(size_t)t * HYW + c] = (bf16_t)(pk_bf16(ya, ya) & 0xffffu);
            YHY[(size_t)(SEQL + t) * HYW + c] = (bf16_t)(pk_bf16(yb, yb) & 0xffffu);
        }
    }
}

__device__ __forceinline__ void attention_phase(unsigned char* lds) {
    const Params p = get_params(); const int bid = BID(), nblk = NBLK();
    const att::bf16* QKV = (const att::bf16*)(p.ws + WS_QKV); att::bf16* YAT = (att::bf16*)(p.ws + WS_YAT);
    for (int item = bid; item < NB * NH * (SEQL / 256); item += nblk) {
        const int b = item >> 8, h = (item >> 5) & 7, qb = item & 31, kvh = h >> 2;
        const att::bf16* Q = QKV + ((size_t)b * SEQL + qb * 256) * 1536 + h * HD;
        const att::bf16* K = QKV + ((size_t)b * SEQL) * 1536 + QW + kvh * HD;
        const att::bf16* V = K + KVW;
        att::bf16* O = YAT + ((size_t)b * SEQL + qb * 256) * QW + h * HD;
        __syncthreads();
        att::attn_dense_body<att::bf16>(Q, K, V, O, SEQL, (char*)lds);
    }
    __syncthreads();
}

template <int MODE>
__device__ __forceinline__ void gemm_step(unsigned char* lds, size_t a_off, size_t b_off, int N, int K, size_t o_off, int ldc, int gofs) {
    const Params p = get_params(); unsigned char* ws = p.ws;
    EpiX<MODE> E{(bf16_t*)(ws + o_off), ldc, (bf16_t*)(ws + WS_QKV), (bf16_t*)(ws + WS_G), (const bf16_t*)(ws + WS_G), gofs};
    run_gemm<MODE>(lds, (const bf16_t*)(ws + a_off), (const bf16_t*)(ws + b_off), N, K, E);
}
__global__ void __launch_bounds__(NTHR) hyena_gqa_mega(Params p_unused) {
    extern __shared__ __attribute__((aligned(16))) unsigned char lds[];
    cg::grid_group grid = cg::this_grid();

    convert_weights_phase(0, lds);
    ln_phase<0>(1, 2, 0);
    hdn_phase(lds);
    grid.sync();

#pragma nounroll
    for (int layer = 0; layer < DEPTH; ++layer) {
        gemm_step<0>(lds, WS_HB, WS_WIN, NIN, DM, WS_PH, 3072, 0);
        grid.sync();
        hyena_pre_phase(layer, lds);
        qk_rope_phase(layer);
        grid.sync();
        fft_conv_phase(layer, lds);
        attention_phase(lds);
        grid.sync();
        gemm_step<1>(lds, WS_YHY, WS_WHY, DM, HYW, WS_MRG, DM, 0);
        gemm_step<2>(lds, WS_YAT, WS_WAT, DM, QW, WS_MRG, DM, DM);
        grid.sync();
        gemm_step<3>(lds, WS_MRG, WS_WO, DM, DM, WS_DLT, DM, 0);
        grid.sync();
        ln_phase<1>(18, 19, layer);
        grid.sync();
        gemm_step<4>(lds, WS_HB, WS_WUP, DFF, DM, WS_FF, DFF, 0);
        grid.sync();
        gemm_step<3>(lds, WS_FF, WS_WDN, DM, DFF, WS_DLT, DM, 0);
        grid.sync();
        ln_phase<1>(22, 23, layer);
        if (layer + 1 < DEPTH) { convert_weights_phase(layer + 1, lds); grid.sync(); }
    }
}

extern "C" void kernel_launch(void* const* d_in, const int* in_sizes, int n_in, void* d_out, int out_size, void* d_ws, size_t ws_size, hipStream_t stream) {
    static int grid_blocks = 0;
    if (grid_blocks == 0) {
        if (n_in != 24 || out_size != NTOK * DM || ws_size < WS_END) { fprintf(stderr, "kernel_launch: unexpected shapes (n_in %d out %d ws %zu need %zu)\n", n_in, out_size, ws_size, (size_t)WS_END); grid_blocks = -1; return; }
        int dev = 0, cus = 0, per_cu = 0;
        hipGetDevice(&dev); hipDeviceGetAttribute(&cus, hipDeviceAttributeMultiprocessorCount, dev);
        if (hipFuncSetAttribute((const void*)hyena_gqa_mega, hipFuncAttributeMaxDynamicSharedMemorySize, LDS_BYTES) != hipSuccess) { fprintf(stderr, "kernel_launch: hipFuncSetAttribute failed\n"); grid_blocks = -1; return; }
        hipOccupancyMaxActiveBlocksPerMultiprocessor(&per_cu, (const void*)hyena_gqa_mega, NTHR, LDS_BYTES);
        if (per_cu < 1) { fprintf(stderr, "kernel_launch: occupancy query says 0 blocks/CU\n"); per_cu = 1; }
        grid_blocks = cus * per_cu;
    }
    if (grid_blocks < 0) return;
    Params p{};
    for (int i = 0; i < 24; ++i) p.in[i] = (const float*)d_in[i];
    p.out = (float*)d_out; p.ws = (unsigned char*)d_ws;
    void* args[] = {&p};
    hipError_t e = hipLaunchCooperativeKernel((const void*)hyena_gqa_mega, dim3(grid_blocks), dim3(NTHR), args, LDS_BYTES, stream);
    if (e != hipSuccess) fprintf(stderr, "cooperative launch failed: %s (grid %d)\n", hipGetErrorString(e), grid_blocks);
}
```

```cpp
#include <hip/hip_runtime.h>
#include <hip/hip_bf16.h>
#include <hip/hip_cooperative_groups.h>
#include <cstdio>
#include <cstdint>
namespace cg = cooperative_groups;

constexpr int DM = 2048, NB = 2, SEQL = 8192, NTOK = NB * SEQL, DEPTH = 2, GRIDW = 64;
constexpr int HYW = 1024, FEMB = 33, FHID = 64, HD = 128, NH = 8, NKV = 2, QW = 1024, KVW = 256, DFF = 8192, NIN = 8704;
constexpr float ALPHA_F = 1.4142135623730951f;
constexpr float LN_EPS = 1e-5f, RMS_EPS = 1e-6f;
constexpr int NTHR = 512;
#ifndef REP_FFT
#define REP_FFT 1
#endif
#ifndef REP_ATT
#define REP_ATT 1
#endif
#ifndef REP_PROJ
#define REP_PROJ 1
#endif
#ifndef REP_CONV
#define REP_CONV 1
#endif
#ifndef REP_HPRE
#define REP_HPRE 1
#endif
#ifndef REP_UP
#define REP_UP 1
#endif
#ifndef REP_SYNC
#define REP_SYNC 1
#endif
#ifndef REP_FOUT
#define REP_FOUT 1
#endif
#ifndef REP_KT
#define REP_KT 1
#endif
#ifndef REP_DOWN
#define REP_DOWN 1
#endif
#ifndef REP_WO
#define REP_WO 1
#endif
#ifndef REP_P4
#define REP_P4 1
#endif
#ifndef REP_LN0
#define REP_LN0 1
#endif
#ifndef REP_HDN
#define REP_HDN 1
#endif


namespace pg8 {
#define PG8_LAS __attribute__((address_space(3)))
typedef unsigned short bf16_t;
typedef short bf16x8 __attribute__((ext_vector_type(8)));
typedef float f32x4 __attribute__((ext_vector_type(4)));
typedef unsigned u32x4 __attribute__((ext_vector_type(4)));
constexpr int BM = 256, BK = 64, HALF = 128, HTB = HALF * BK * 2  , STAGE_BYTES = 8 * HTB, NXCD = 8, WGM = 8;

__host__ __device__ __forceinline__ int lds_byte(int r, int c) { const int st = (r >> 4) * 2 + (c >> 5), rr = r & 15, cc = c & 31, ob = rr * 64 + cc * 2; return st * 1024 + (ob ^ (((ob >> 9) & 1) << 5)); }
__host__ __device__ __forceinline__ void stage_rc(int b, int& R, int& C) { const int st = b / 1024, sb = b % 1024, swz = sb ^ (((sb >> 9) & 1) << 5); R = (st >> 1) * 16 + swz / 64; C = (st & 1) * 32 + (swz % 64) / 2; }
__host__ __device__ __forceinline__ int perm32(int rho) { const int n = rho >> 4, i = rho & 15; return 8 * (i >> 2) + 4 * n + (i & 3); }

struct Unit { int pm, pn; };
struct Gemm { const bf16_t* A; const bf16_t* Bt; int M, N, K; const bf16_t* A2; const bf16_t* Bt2; };

struct StaticOrder {
    int nM, nN, nwg, G, c;
    __host__ __device__ void init(int M, int N, int G_, int c_) { nM = M / BM; nN = N / BM; nwg = nM * nN; G = G_; c = c_; }
    __host__ __device__ bool next(int i, Unit& u) const {
        const long L = (long)i * G + c; if (L >= nwg) return false;
        int wgid = (int)L; { const int q = nwg / NXCD, r = nwg % NXCD, xcd = wgid % NXCD, off = wgid / NXCD; wgid = (xcd < r ? xcd * (q + 1) : r * (q + 1) + (xcd - r) * q) + off; }
        const int nig = WGM * nN, gid = wgid / nig, fm = gid * WGM, gsz = (nM - fm) < WGM ? (nM - fm) : WGM;
        u.pm = fm + ((wgid % nig) % gsz); u.pn = (wgid % nig) / gsz; return true;
    }
    __device__ __forceinline__ void a_ready(const Unit&) const {}
    __device__ __forceinline__ void done(const Unit&) const {}
};
__device__ __forceinline__ unsigned cvt_pk_bf16(float lo, float hi) { unsigned r; asm volatile("v_cvt_pk_bf16_f32 %0, %1, %2" : "=v"(r) : "v"(lo), "v"(hi)); return r; }
template <class Epi, class Sched, bool DUAL = false>
__device__ __forceinline__ void gemm_phase(PG8_LAS unsigned char* lds, const Gemm g, const Sched& S, const Epi& E) {
    int tid_ = threadIdx.x; asm volatile("" : "+v"(tid_)); const int tid = tid_, wid = __builtin_amdgcn_readfirstlane(tid >> 6), lane = tid & 63, wr = wid >> 2, wc = wid & 3, fr = lane & 15, fq = lane >> 4;
    const int K = g.K, nt = K / BK;
    unsigned voffA[2], voffB[2];
#pragma unroll
    for (int i = 0; i < 2; ++i) { int R, C; stage_rc(tid * 16 + i * 8192, R, C); const int Rb = Epi::PERM ? ((R & ~31) + perm32(R & 31)) : R;
        voffA[i] = (unsigned)(R * K + C) * 2u; voffB[i] = (unsigned)(Rb * K + C) * 2u; }
    const size_t kstep = (size_t)(BK * 2);
    const size_t hstep = (size_t)HALF * K * 2;
    const size_t tstep = 2 * hstep;
    const unsigned ldsw = (unsigned)wid * 1024u;
    const int aoff = lds_byte(wr * 64 + fr, fq * 8), boff = lds_byte(wc * 32 + fr, fq * 8);
#define PG8_SA(b, h) (((b) * 2 + (h)) * HTB)
#define PG8_SB(b, h) ((4 + (b) * 2 + (h)) * HTB)
#define PG8_STAGE(bufoff, gbase, voff) do { _Pragma("unroll") for (int _i = 0; _i < 2; ++_i) \
        __builtin_amdgcn_global_load_lds((const unsigned*)((const char*)(gbase) + (voff)[_i]), (PG8_LAS unsigned*)(lds + (bufoff) + ldsw + _i * 8192), 16, 0, 0); } while (0)
#define PG8_LDA(dst, b, h) do { _Pragma("unroll") for (int m = 0; m < 4; ++m) _Pragma("unroll") for (int k = 0; k < 2; ++k) dst[m][k] = *(const PG8_LAS bf16x8*)(lds + PG8_SA(b, h) + aoff + m * 2048 + k * 1024); } while (0)
#define PG8_LDB(dst, b, h) do { _Pragma("unroll") for (int n = 0; n < 2; ++n) _Pragma("unroll") for (int k = 0; k < 2; ++k) dst[n][k] = *(const PG8_LAS bf16x8*)(lds + PG8_SB(b, h) + boff + n * 2048 + k * 1024); } while (0)
#define PG8_MMA(ai, bj, At, Bt) do { __builtin_amdgcn_s_setprio(1); _Pragma("unroll") for (int m = 0; m < 4; ++m) _Pragma("unroll") for (int n = 0; n < 2; ++n) _Pragma("unroll") for (int k = 0; k < 2; ++k) \
        acc[ai][bj][m][n] = __builtin_amdgcn_mfma_f32_16x16x32_bf16(Bt[n][k], At[m][k], acc[ai][bj][m][n], 0, 0, 0); __builtin_amdgcn_s_setprio(0); } while (0)
#define PG8_WAIT_V(n) asm volatile("s_waitcnt vmcnt(" #n ")" ::: "memory")
#define PG8_WAIT_L(n) asm volatile("s_waitcnt lgkmcnt(" #n ")" ::: "memory")
#define PG8_BAR __builtin_amdgcn_s_barrier()
#define PG8_SCHED __builtin_amdgcn_sched_barrier(0)
    Unit cur, nxt; int ui = 0;
    if (!S.next(0, cur)) return;
    f32x4 acc[2][2][4][2];
#pragma unroll
    for (int a = 0; a < 2; ++a)
#pragma unroll
        for (int b = 0; b < 2; ++b)
#pragma unroll
            for (int m = 0; m < 4; ++m)
#pragma unroll
                for (int n = 0; n < 2; ++n) acc[a][b][m][n] = (f32x4){0.f, 0.f, 0.f, 0.f};
    bf16x8 At[4][2], B0[2][2], B1[2][2];
    const char* cA = (const char*)g.A + (size_t)cur.pm * tstep; const char* cB = (const char*)g.Bt + (size_t)cur.pn * tstep;
    S.a_ready(cur);
    PG8_STAGE(PG8_SB(0, 0), cB, voffB); PG8_STAGE(PG8_SA(0, 0), cA, voffA); PG8_STAGE(PG8_SB(0, 1), cB + hstep, voffB); PG8_STAGE(PG8_SA(0, 1), cA + hstep, voffA);
    if (wr == 1) PG8_BAR;
    PG8_WAIT_V(4); PG8_BAR;
    PG8_STAGE(PG8_SB(1, 0), cB + kstep, voffB); PG8_STAGE(PG8_SA(1, 0), cA + kstep, voffA); PG8_STAGE(PG8_SB(1, 1), cB + hstep + kstep, voffB);
    PG8_WAIT_V(6); PG8_BAR;
    const char* cA2 = DUAL ? (const char*)g.A2 + (size_t)cur.pm * tstep : cA; const char* cB2 = DUAL ? (const char*)g.Bt2 + (size_t)cur.pn * tstep : cB;
    const int ntt = DUAL ? 2 * nt : nt;
    for (;;) {
        const bool has_next = S.next(ui + 1, nxt);
        const char* nA = has_next ? (const char*)g.A + (size_t)nxt.pm * tstep : cA; const char* nB = has_next ? (const char*)g.Bt + (size_t)nxt.pn * tstep : cB;
        for (int t = 0; t < ntt; t += 2) {
            const bool last = (t == ntt - 2);
            const bool s1 = DUAL && (t + 1 >= nt), s2 = DUAL && (t + 2 >= nt);
            const char* a1 = (s1 ? cA2 + (size_t)(t + 1 - nt) * kstep : cA + (size_t)(t + 1) * kstep);
            const char* a2 = last ? nA : (s2 ? cA2 + (size_t)(t + 2 - nt) * kstep : cA + (size_t)(t + 2) * kstep);
            const char* b2 = last ? nB : (s2 ? cB2 + (size_t)(t + 2 - nt) * kstep : cB + (size_t)(t + 2) * kstep);
            const char* a3 = a2 + kstep; const char* b3 = b2 + kstep;
            if (last && has_next) S.a_ready(nxt);
            PG8_LDB(B0, 0, 0); PG8_SCHED; PG8_LDA(At, 0, 0); PG8_STAGE(PG8_SA(1, 1), a1 + hstep, voffA);
            PG8_WAIT_L(8); PG8_BAR; PG8_WAIT_L(0); PG8_MMA(0, 0, At, B0); PG8_BAR; PG8_SCHED;
            PG8_LDB(B1, 0, 1); PG8_STAGE(PG8_SB(0, 0), b2, voffB);
            PG8_BAR; PG8_WAIT_L(0); PG8_MMA(0, 1, At, B1); PG8_BAR;
            PG8_LDA(At, 0, 1); PG8_STAGE(PG8_SA(0, 0), a2, voffA);
            PG8_BAR; PG8_WAIT_L(0); PG8_MMA(1, 0, At, B0); PG8_BAR; PG8_SCHED;
            PG8_STAGE(PG8_SB(0, 1), b2 + hstep, voffB);
            PG8_WAIT_V(6); PG8_BAR; PG8_MMA(1, 1, At, B1); PG8_BAR;
            PG8_LDB(B0, 1, 0); PG8_SCHED; PG8_LDA(At, 1, 0); PG8_STAGE(PG8_SA(0, 1), a2 + hstep, voffA);
            PG8_WAIT_L(8); PG8_BAR; PG8_WAIT_L(0); PG8_MMA(0, 0, At, B0); PG8_BAR; PG8_SCHED;
            PG8_LDB(B1, 1, 1); PG8_STAGE(PG8_SB(1, 0), b3, voffB);
            PG8_BAR; PG8_WAIT_L(0); PG8_MMA(0, 1, At, B1); PG8_BAR;
            PG8_LDA(At, 1, 1); PG8_STAGE(PG8_SA(1, 0), a3, voffA);
            PG8_BAR; PG8_WAIT_L(0); PG8_MMA(1, 0, At, B0); PG8_BAR; PG8_SCHED;
            PG8_STAGE(PG8_SB(1, 1), b3 + hstep, voffB);
            PG8_WAIT_V(6); PG8_BAR; PG8_MMA(1, 1, At, B1); PG8_BAR;
            if constexpr (DUAL) { if (t == nt - 2) E.mid(acc, cur, wr, wc, fr, fq); }
        }
        if constexpr (!Epi::AFTER_DRAIN) { E(acc, cur, wr, wc, fr, fq); S.done(cur); }
        if (!has_next) break;
#pragma unroll
        for (int a = 0; a < 2; ++a)
#pragma unroll
            for (int b = 0; b < 2; ++b)
#pragma unroll
                for (int m = 0; m < 4; ++m)
#pragma unroll
                    for (int n = 0; n < 2; ++n) acc[a][b][m][n] = (f32x4){0.f, 0.f, 0.f, 0.f};
        cur = nxt; cA = nA; cB = nB; ++ui;
        if (DUAL) { cA2 = (const char*)g.A2 + (size_t)cur.pm * tstep; cB2 = (const char*)g.Bt2 + (size_t)cur.pn * tstep; }
    }
    PG8_WAIT_V(0);
    if (wr == 0) PG8_BAR;
    PG8_BAR;
    if constexpr (Epi::AFTER_DRAIN) { E.fused(acc, cur, wr, wc, fr, fq, lds, wid, lane); S.done(cur); }
#undef PG8_SA
#undef PG8_SB
#undef PG8_STAGE
#undef PG8_LDA

#undef PG8_LDB
#undef PG8_MMA
#undef PG8_WAIT_V
#undef PG8_WAIT_L
#undef PG8_BAR
#undef PG8_SCHED
}
}
namespace att {
using bf16 = __hip_bfloat16;
constexpr int   D = 128, NW = 8, QBLK = 32, KVBLK = 64;
constexpr float SCALE = 0.088388347648318440f;
constexpr float THR = 8.f;
constexpr int SDEPTH = 2;
constexpr int LDQ = 1536, LDK = 1536, LDO = 1024;
constexpr size_t SHM_V = KVBLK * D * 2, SHM_K = KVBLK * D * 2, SHM_ATTN = 2 * SHM_V + 2 * SHM_K + NW * 64 * 4;
using u32x4  = __attribute__((ext_vector_type(4))) unsigned;

using bf16x8 = __attribute__((ext_vector_type(8))) short;
using s16x4  = __attribute__((ext_vector_type(4))) short;
using f32x16 = __attribute__((ext_vector_type(16))) float;
using f32x8  = __attribute__((ext_vector_type(8))) float;
#define KSWZ(row, colB) ((row) * 256 + ((colB) ^ (((row) & 7) << 4)))
#define SBAR() __builtin_amdgcn_sched_barrier(0)
__device__ __forceinline__ int crow(int r, int hi) { return (r & 3) + 8 * (r >> 2) + 4 * hi; }
__device__ __forceinline__ unsigned cvtpk(float lo, float hi) {
  unsigned r; asm volatile("v_cvt_pk_bf16_f32 %0, %1, %2" : "=v"(r) : "v"(lo), "v"(hi)); return r;
}
template <typename TIn> struct Stage;
template <> struct Stage<bf16>  { using T = bf16x8;
  __device__ static __forceinline__ T ld8(const bf16* p) { return *reinterpret_cast<const bf16x8*>(p); }
  __device__ static __forceinline__ bf16x8 tobf(T x) { return x; } };
template <> struct Stage<float> { using T = f32x8;
  __device__ static __forceinline__ T ld8(const float* p) { return *reinterpret_cast<const f32x8*>(p); }
  __device__ static __forceinline__ bf16x8 tobf(T x) {
    u32x4 w = {cvtpk(x[0], x[1]), cvtpk(x[2], x[3]), cvtpk(x[4], x[5]), cvtpk(x[6], x[7])}; return *reinterpret_cast<bf16x8*>(&w); } };

__device__ __forceinline__ void partialSM(f32x16& p0, f32x16& p1, float& m_reg, float& mn, float& alpha) {
  constexpr float C = SCALE * 1.4426950408889634f;
  float pmax = p0[0]; for (int r = 1; r < 16; ++r) pmax = fmaxf(pmax, p0[r]); for (int r = 0; r < 16; ++r) pmax = fmaxf(pmax, p1[r]);
  { auto rr = __builtin_amdgcn_permlane32_swap(__float_as_uint(pmax), __float_as_uint(pmax), false, false);
    pmax = fmaxf(__uint_as_float(rr[0]), __uint_as_float(rr[1])); }
  if (__builtin_expect(__all(pmax - m_reg <= THR / SCALE), 1)) { mn = m_reg; alpha = 1.f; }
  else { mn = fmaxf(m_reg, pmax); alpha = __builtin_amdgcn_exp2f((m_reg - mn) * C); m_reg = mn; }
  float mnC = -mn * C;
  for (int r = 0; r < 16; ++r) p0[r] = fmaf(p0[r], C, mnC); for (int r = 0; r < 16; ++r) p1[r] = fmaf(p1[r], C, mnC);
  for (int r = 0; r < 16; ++r) p0[r] = __builtin_amdgcn_exp2f(p0[r]);
}
__device__ __forceinline__ void finishSM(f32x16& p0, f32x16& p1, float alpha, float& l_reg, bf16x8& pa0, bf16x8& pa1, bf16x8& pa2, bf16x8& pa3) {
  for (int r = 0; r < 16; ++r) p1[r] = __builtin_amdgcn_exp2f(p1[r]);
  float ps = 0; for (int r = 0; r < 16; ++r) ps += p0[r]; for (int r = 0; r < 16; ++r) ps += p1[r];
  { auto rr = __builtin_amdgcn_permlane32_swap(__float_as_uint(ps), __float_as_uint(ps), false, false);
    ps = __uint_as_float(rr[0]) + __uint_as_float(rr[1]); }
  l_reg = l_reg * alpha + ps;
#define PK4(P, BASE, OUT) do { unsigned a0 = cvtpk(P[BASE + 0], P[BASE + 1]), a1 = cvtpk(P[BASE + 2], P[BASE + 3]);   \
    unsigned b0 = cvtpk(P[BASE + 4], P[BASE + 5]), b1 = cvtpk(P[BASE + 6], P[BASE + 7]);                              \
    auto r0 = __builtin_amdgcn_permlane32_swap(a0, b0, false, false); auto r1 = __builtin_amdgcn_permlane32_swap(a1, b1, false, false); \
    u32x4 w = {r0[0], r1[0], r0[1], r1[1]}; OUT = *reinterpret_cast<bf16x8*>(&w); } while (0)
  PK4(p0, 0, pa0); PK4(p0, 8, pa1); PK4(p1, 0, pa2); PK4(p1, 8, pa3);
#undef PK4
}
__device__ __forceinline__ void qkt(f32x16& p0, f32x16& p1, const bf16* Ks, const bf16x8* qr, int r32, int hi) {
  p0 = f32x16{}; p1 = f32x16{};
  for (int d0 = 0; d0 < 8; ++d0) { int cb = (d0 * 16 + hi * 8) * 2;
    bf16x8 b0 = *reinterpret_cast<const bf16x8*>((const char*)Ks + KSWZ(r32, cb));
    bf16x8 b1 = *reinterpret_cast<const bf16x8*>((const char*)Ks + KSWZ(32 + r32, cb));
    p0 = __builtin_amdgcn_mfma_f32_32x32x16_bf16(b0, qr[d0], p0, 0, 0, 0);
    p1 = __builtin_amdgcn_mfma_f32_32x32x16_bf16(b1, qr[d0], p1, 0, 0, 0); }
}
__device__ __forceinline__ int v_st(int k, int c) { const int kk = (k & ~0xC) | ((k & 4) << 1) | ((k & 8) >> 1); return ((kk >> 3) * 4 + (c >> 5)) * 512 + ((kk & 7) * 32 + (c & 31)) * 2; }
__device__ __forceinline__ int v_rd_base(int lane) { return ((lane & 3) << 3) | (((lane >> 2) & 3) << 6) | (((lane >> 4) & 1) << 5) | (((lane >> 5) & 1) << 8); }
constexpr int v_rd_off(int d0, int ks, int half) { return d0 * 512 + ks * 4096 + half * 2048; }
template <int OFF> __device__ __forceinline__ s16x4 tr_read(int vb) {
  s16x4 r; asm volatile("ds_read_b64_tr_b16 %0, %1 offset:%2" : "=&v"(r) : "v"(vb), "i"(OFF) : "memory"); return r;
}
template <int D0> __device__ __forceinline__ void pv_one(f32x16& od, int vb, bf16x8 pa0, bf16x8 pa1, bf16x8 pa2, bf16x8 pa3) {
  const s16x4 l0 = tr_read<v_rd_off(D0, 0, 0)>(vb), h0 = tr_read<v_rd_off(D0, 0, 1)>(vb), l1 = tr_read<v_rd_off(D0, 1, 0)>(vb), h1 = tr_read<v_rd_off(D0, 1, 1)>(vb);
  const s16x4 l2 = tr_read<v_rd_off(D0, 2, 0)>(vb), h2 = tr_read<v_rd_off(D0, 2, 1)>(vb), l3 = tr_read<v_rd_off(D0, 3, 0)>(vb), h3 = tr_read<v_rd_off(D0, 3, 1)>(vb);
  asm volatile("s_waitcnt lgkmcnt(0)" ::: "memory"); SBAR();
#define PK(L, H) (bf16x8){L[0], L[1], L[2], L[3], H[0], H[1], H[2], H[3]}
  od = __builtin_amdgcn_mfma_f32_32x32x16_bf16(pa0, PK(l0, h0), od, 0, 0, 0);
  od = __builtin_amdgcn_mfma_f32_32x32x16_bf16(pa1, PK(l1, h1), od, 0, 0, 0);
  od = __builtin_amdgcn_mfma_f32_32x32x16_bf16(pa2, PK(l2, h2), od, 0, 0, 0);
  od = __builtin_amdgcn_mfma_f32_32x32x16_bf16(pa3, PK(l3, h3), od, 0, 0, 0);
#undef PK
}
__device__ __forceinline__ void pv_d0(f32x16* o, int vb, bf16x8 pa0, bf16x8 pa1, bf16x8 pa2, bf16x8 pa3) {
  pv_one<0>(o[0], vb, pa0, pa1, pa2, pa3); pv_one<1>(o[1], vb, pa0, pa1, pa2, pa3); pv_one<2>(o[2], vb, pa0, pa1, pa2, pa3); pv_one<3>(o[3], vb, pa0, pa1, pa2, pa3);
}

template <typename TQ>
__device__ __forceinline__ void attn_dense_body(const TQ* __restrict__ Qb, const bf16* __restrict__ Kh, const bf16* __restrict__ Vh,
                                                bf16* __restrict__ Ob, int seq, char* lds) {
  using St = Stage<bf16>; using SQ = Stage<TQ>;
  int tid_ = threadIdx.x; asm volatile("" : "+v"(tid_)); const int tid = tid_, wid = tid >> 6, lane = tid & 63, r32 = lane & 31, hi = lane >> 5;
  bf16* V_lds = (bf16*)lds; bf16* K_lds = (bf16*)(lds + 2 * SHM_V);
  float* ws = (float*)(lds + 2 * SHM_V + 2 * SHM_K) + wid * 64; float* li_l = ws; float* al_l = ws + 32;
  float m_reg = -1e30f, l_reg = 0; f32x16 o[4] = {}; bf16x8 qr[8];
  const TQ* Qw = Qb + (long)(wid * QBLK + r32) * LDQ + hi * 8;
#pragma unroll
  for (int d0 = 0; d0 < 8; ++d0) qr[d0] = SQ::tobf(SQ::ld8(Qw + d0 * 16));
  const int sr = tid >> 4, sc = (tid & 15) * 8, vst0 = v_st(sr, sc), vst1 = v_st(32 + sr, sc);
  const int vb0 = (int)(uintptr_t)V_lds + v_rd_base(lane);
  struct { typename St::T vs0, vs1, ks0, ks1; } sr_[SDEPTH];
#define SLOAD(i, k0) do { sr_[i].vs0 = St::ld8(&Vh[(long)((k0) + sr) * LDK + sc]); sr_[i].vs1 = St::ld8(&Vh[(long)((k0) + 32 + sr) * LDK + sc]); \
    sr_[i].ks0 = St::ld8(&Kh[(long)((k0) + sr) * LDK + sc]); sr_[i].ks1 = St::ld8(&Kh[(long)((k0) + 32 + sr) * LDK + sc]); } while (0)
#define SWRITE(b, i) do { *(bf16x8*)((char*)V_lds + (b) * SHM_V + vst0) = St::tobf(sr_[i].vs0);          \
    *(bf16x8*)((char*)V_lds + (b) * SHM_V + vst1) = St::tobf(sr_[i].vs1); int kc = sc * 2;               \
    *(bf16x8*)((char*)K_lds + (b) * SHM_K + KSWZ(sr, kc)) = St::tobf(sr_[i].ks0);                       \
    *(bf16x8*)((char*)K_lds + (b) * SHM_K + KSWZ(32 + sr, kc)) = St::tobf(sr_[i].ks1); } while (0)
#define SWAIT() do { if constexpr (SDEPTH == 2) asm volatile("s_waitcnt vmcnt(4)" ::: "memory"); else asm volatile("s_waitcnt vmcnt(0)" ::: "memory"); } while (0)
#define RESC(a) do { if (__any((a) < 1.f)) { if (hi == 0) al_l[r32] = (a); asm volatile("s_waitcnt lgkmcnt(0)" ::: "memory"); \
    for (int d = 0; d < 4; ++d) for (int r = 0; r < 16; ++r) o[d][r] *= al_l[crow(r, hi)]; } } while (0)
  f32x16 pA0, pA1, pB0, pB1; float mnA, mnB, alA, alB; bf16x8 pa0, pa1, pa2, pa3; const int NT = seq / KVBLK;
  constexpr int SE = 0, SO = SDEPTH - 1;
  SLOAD(SE, 0); asm volatile("s_waitcnt vmcnt(0)" ::: "memory"); SWRITE(0, SE); __syncthreads();
  qkt(pA0, pA1, K_lds, qr, r32, hi); partialSM(pA0, pA1, m_reg, mnA, alA);
  SLOAD(SO, KVBLK); if constexpr (SDEPTH == 2) { if (2 < NT) SLOAD(SE, 2 * KVBLK); }
  SWAIT(); SWRITE(1, SO); __syncthreads();
  for (int j = 1; j + 1 < NT; j += 2) {
    SBAR(); qkt(pB0, pB1, (bf16*)((char*)K_lds + SHM_K), qr, r32, hi);
    finishSM(pA0, pA1, alA, l_reg, pa0, pa1, pa2, pa3); SBAR();
    SLOAD(SO, (j + SDEPTH) * KVBLK); SBAR();
    pv_d0(o, vb0, pa0, pa1, pa2, pa3); partialSM(pB0, pB1, m_reg, mnB, alB);
    __syncthreads(); SWAIT(); SWRITE(0, SE);
    RESC(alB); __syncthreads();
    SBAR(); qkt(pA0, pA1, K_lds, qr, r32, hi);
    finishSM(pB0, pB1, alB, l_reg, pa0, pa1, pa2, pa3); SBAR();
    if (SDEPTH == 1 || j + 3 < NT) SLOAD(SE, (j + 1 + SDEPTH) * KVBLK); SBAR();
    pv_d0(o, vb0 + (int)SHM_V, pa0, pa1, pa2, pa3); partialSM(pA0, pA1, m_reg, mnA, alA);
    __syncthreads(); SWAIT(); SWRITE(1, SO);
    RESC(alA); __syncthreads();
  }
  SBAR(); qkt(pB0, pB1, (bf16*)((char*)K_lds + SHM_K), qr, r32, hi);
  finishSM(pA0, pA1, alA, l_reg, pa0, pa1, pa2, pa3); SBAR();
  pv_d0(o, vb0, pa0, pa1, pa2, pa3); partialSM(pB0, pB1, m_reg, mnB, alB);
  __syncthreads(); RESC(alB);
  finishSM(pB0, pB1, alB, l_reg, pa0, pa1, pa2, pa3); SBAR();
  pv_d0(o, vb0 + (int)SHM_V, pa0, pa1, pa2, pa3);
  if (hi == 0) li_l[r32] = l_reg; asm volatile("s_waitcnt lgkmcnt(0)" ::: "memory");
  float rli[16];
#pragma unroll
  for (int r = 0; r < 16; ++r) rli[r] = __builtin_amdgcn_rcpf(li_l[crow(r, hi)]);
  bf16* Ow = Ob + (long)(wid * QBLK) * LDO;
#pragma unroll
  for (int r = 0; r < 16; ++r) { int orow = crow(r, hi);
#pragma unroll
    for (int d0 = 0; d0 < 4; ++d0) Ow[(long)orow * LDO + d0 * 32 + r32] = __float2bfloat16(o[d0][r] * rli[r]); }
#undef SLOAD
#undef SWRITE
#undef SWAIT
#undef RESC
}

#undef KSWZ
}

#define LAS __attribute__((address_space(3)))
typedef unsigned short bf16_t;
typedef float f32x2 __attribute__((ext_vector_type(2)));
typedef float f32x4 __attribute__((ext_vector_type(4)));
typedef unsigned u32x4 __attribute__((ext_vector_type(4)));
typedef unsigned u32x2 __attribute__((ext_vector_type(2)));

struct Params { const float* in[24]; float* out; unsigned char* ws; };
typedef const __attribute__((address_space(4))) Params* ParamsPtr;
#if defined(__HIP_DEVICE_COMPILE__)
__device__ __forceinline__ Params get_params() { ParamsPtr q = (ParamsPtr)__builtin_amdgcn_kernarg_segment_ptr(); asm volatile("" : "+s"(q)); return *q; }
#else
__device__ __forceinline__ Params get_params() { return Params{}; }
#endif
__device__ __forceinline__ int lv(int x) { asm volatile("" : "+v"(x)); return x; }
__device__ __forceinline__ int ls(int x) { asm volatile("" : "+s"(x)); return x; }
#define TID() lv((int)threadIdx.x)
#define BID() ls((int)blockIdx.x)
#define NBLK() ls((int)gridDim.x)

constexpr size_t SZ_WIN = (size_t)NIN * DM * 2, SZ_WHY = (size_t)DM * HYW * 2, SZ_WAT = (size_t)DM * QW * 2, SZ_WO = (size_t)DM * DM * 2, SZ_WUP = (size_t)DFF * DM * 2, SZ_WDN = (size_t)DM * DFF * 2;
constexpr size_t WS_WIN = 0, WS_WHY = WS_WIN + SZ_WIN, WS_WAT = WS_WHY + SZ_WHY, WS_WO = WS_WAT + SZ_WAT, WS_WUP = WS_WO + SZ_WO, WS_WDN = WS_WUP + SZ_WUP;
constexpr size_t WS_HB = WS_WDN + SZ_WDN;

constexpr size_t WS_X = WS_HB + (size_t)NTOK * DM * 2;
constexpr size_t WS_PH = WS_X, WS_QKV = WS_PH + (size_t)NTOK * 3072 * 2, WS_G = WS_QKV + (size_t)NTOK * 1536 * 2;
constexpr size_t WS_FF = WS_X, WS_YHY = WS_PH, WS_YAT = WS_PH + (size_t)NTOK * HYW * 2, WS_YT = WS_YAT + (size_t)NTOK * QW * 2, WS_MRG = WS_YT;
constexpr size_t WS_R = WS_X + (size_t)NTOK * NIN * 2;
constexpr size_t WS_Z = WS_R, WS_X0T = WS_R + (size_t)HYW * NTOK * 4, WS_RB = WS_R;
constexpr size_t WS_HDN = WS_X0T + (size_t)HYW * NTOK * 2;
constexpr size_t WS_ROPE = WS_HDN + (size_t)DEPTH * SEQL * FHID * 4;
constexpr size_t WS_BAR = WS_ROPE + 128 * 32 * 8;
constexpr size_t WS_STATS = WS_BAR + 3456 * 4;
constexpr size_t WS_PUIN = WS_STATS + (size_t)3 * NTOK * 2 * 4;
constexpr size_t WS_PVIN = WS_PUIN + (size_t)NIN * 4, WS_PUUP = WS_PVIN + (size_t)NIN * 4, WS_PVUP = WS_PUUP + (size_t)DFF * 4;
constexpr size_t WS_END = WS_PVUP + (size_t)DFF * 4;

constexpr int FFTN = 16384, FFT_LDS = (FFTN + FFTN / 16) * 8;
constexpr int XST_OFF = FFT_LDS + 1024 + (1024 + 128 + 16) * 8;
constexpr int LDS_BYTES = XST_OFF + 16;

__device__ __forceinline__ float bf_lo(unsigned w) { return __uint_as_float(w << 16); }
__device__ __forceinline__ float bf_hi(unsigned w) { return __uint_as_float(w & 0xffff0000u); }
__device__ __forceinline__ unsigned pk_bf16(float lo, float hi) { return pg8::cvt_pk_bf16(lo, hi); }

struct LnFold { const float* stats; const float* g; const float* b; const float* pu; const float* pv; };
__device__ __forceinline__ void ln_row_stats(const float* stats, size_t r, float& mean, float& rstd) {
    const f32x2 sq = *(const f32x2*)(stats + 2 * r); mean = sq.x * (1.0f / DM); rstd = rsqrtf(fmaxf(sq.y * (1.0f / DM) - mean * mean, 0.f) + LN_EPS);
}
#define PIN16F(A, B) asm volatile("" : "+v"(A[B]), "+v"(A[B + 1]), "+v"(A[B + 2]), "+v"(A[B + 3]), "+v"(A[B + 4]), "+v"(A[B + 5]), "+v"(A[B + 6]), "+v"(A[B + 7]), \
    "+v"(A[B + 8]), "+v"(A[B + 9]), "+v"(A[B + 10]), "+v"(A[B + 11]), "+v"(A[B + 12]), "+v"(A[B + 13]), "+v"(A[B + 14]), "+v"(A[B + 15]))
__device__ __forceinline__ void pin4(u32x4& a, u32x4& b, u32x4& c, u32x4& d) { asm volatile("" : "+v"(a), "+v"(b), "+v"(c), "+v"(d)); }
__device__ __forceinline__ void pin4f(f32x4& a, f32x4& b, f32x4& c, f32x4& d) { asm volatile("" : "+v"(a), "+v"(b), "+v"(c), "+v"(d)); }
__device__ __forceinline__ void pin8(u32x4& a, u32x4& b, u32x4& c, u32x4& d, u32x4& e, u32x4& f, u32x4& g, u32x4& h) { asm volatile("" : "+v"(a), "+v"(b), "+v"(c), "+v"(d), "+v"(e), "+v"(f), "+v"(g), "+v"(h)); }
__device__ __forceinline__ void pin8f(f32x4& a, f32x4& b, f32x4& c, f32x4& d, f32x4& e, f32x4& f, f32x4& g, f32x4& h) { asm volatile("" : "+v"(a), "+v"(b), "+v"(c), "+v"(d), "+v"(e), "+v"(f), "+v"(g), "+v"(h)); }
template <int MODE> struct EpiX {
    static constexpr bool PERM = true, AFTER_DRAIN = false;
    bf16_t* O; int ldc; bf16_t* O2; bf16_t* O3; const bf16_t* G; int gofs; LnFold f; float* stats_out;
    __device__ __forceinline__ void mid(pg8::f32x4 (&acc)[2][2][4][2], const pg8::Unit& u, int wr, int wc, int fr, int fq) const {
        const int row0 = lv(u.pm * 256 + wr * 64 + fr), col0 = u.pn * 256 + wc * 32 + 8 * fq;
#pragma unroll
        for (int ai = 0; ai < 2; ++ai)
#pragma unroll
            for (int mp = 0; mp < 2; ++mp) {
                u32x4 gh[2][2], ga[2][2];
#pragma unroll
                for (int mm = 0; mm < 2; ++mm)
#pragma unroll
                    for (int bj = 0; bj < 2; ++bj) { const size_t r = (size_t)(row0 + ai * 128 + (mp * 2 + mm) * 16);
                        gh[mm][bj] = *(const u32x4*)(G + r * 4096 + col0 + bj * 128); ga[mm][bj] = *(const u32x4*)(G + r * 4096 + DM + col0 + bj * 128); }
                pin8(gh[0][0], gh[0][1], gh[1][0], gh[1][1], ga[0][0], ga[0][1], ga[1][0], ga[1][1]);
#pragma unroll
                for (int mm = 0; mm < 2; ++mm)
#pragma unroll
                    for (int bj = 0; bj < 2; ++bj) { const int m = mp * 2 + mm; const u32x4 h = gh[mm][bj], a = ga[mm][bj];
                        acc[ai][bj][m][0][0] *= bf_lo(h.x) * __builtin_amdgcn_rcpf(bf_lo(a.x)); acc[ai][bj][m][0][1] *= bf_hi(h.x) * __builtin_amdgcn_rcpf(bf_hi(a.x));
                        acc[ai][bj][m][0][2] *= bf_lo(h.y) * __builtin_amdgcn_rcpf(bf_lo(a.y)); acc[ai][bj][m][0][3] *= bf_hi(h.y) * __builtin_amdgcn_rcpf(bf_hi(a.y));
                        acc[ai][bj][m][1][0] *= bf_lo(h.z) * __builtin_amdgcn_rcpf(bf_lo(a.z)); acc[ai][bj][m][1][1] *= bf_hi(h.z) * __builtin_amdgcn_rcpf(bf_hi(a.z));
                        acc[ai][bj][m][1][2] *= bf_lo(h.w) * __builtin_amdgcn_rcpf(bf_lo(a.w)); acc[ai][bj][m][1][3] *= bf_hi(h.w) * __builtin_amdgcn_rcpf(bf_hi(a.w)); }
            }
    }
    __device__ __forceinline__ void operator()(const pg8::f32x4 (&acc)[2][2][4][2], const pg8::Unit& u, int wr, int wc, int fr, int fq) const {
        const int row0 = lv(u.pm * 256 + wr * 64 + fr); int colt = u.pn * 256; bf16_t* base = O; int ld = ldc; bool sig = false;
        const int colg = u.pn * 256 + wc * 32 + 8 * fq;
        if (MODE == 0) { if (u.pn >= 18) { base = O3; ld = 4096; colt -= 4608; sig = true; } else if (u.pn >= 12) { base = O2; ld = 1536; colt -= 3072; } }
        const int col0 = colt + wc * 32 + 8 * fq;
        constexpr bool FOLD_A = (MODE == 0 || MODE == 4), RES = (MODE == 5), GATE = (MODE == 1 || MODE == 2 || MODE == 6);
        const bool fold = (FOLD_A || RES) && f.stats != nullptr;
        float cu[2][8], cv[2][8]; f32x2 st[2][4];
        if (FOLD_A || RES) {
#pragma unroll
            for (int bj = 0; bj < 2; ++bj)
#pragma unroll
                for (int e = 0; e < 8; ++e) { cu[bj][e] = RES ? 1.f : 0.f; cv[bj][e] = 0.f; }
            if (FOLD_A) {
#pragma unroll
                for (int ai = 0; ai < 2; ++ai)
#pragma unroll
                    for (int m = 0; m < 4; ++m) st[ai][m] = (f32x2){0.f, 0.f}; }
            if (fold) {
                const float* pa = FOLD_A ? f.pu : f.g; const float* pb = FOLD_A ? f.pv : f.b;
                f32x4 t[2][4];
#pragma unroll
                for (int bj = 0; bj < 2; ++bj) { const int c = colg + bj * 128; t[bj][0] = *(const f32x4*)(pa + c); t[bj][1] = *(const f32x4*)(pa + c + 4); t[bj][2] = *(const f32x4*)(pb + c); t[bj][3] = *(const f32x4*)(pb + c + 4); }
                if (FOLD_A) {
#pragma unroll
                    for (int ai = 0; ai < 2; ++ai)
#pragma unroll
                        for (int m = 0; m < 4; ++m) st[ai][m] = *(const f32x2*)(f.stats + 2 * (size_t)(row0 + ai * 128 + m * 16)); }
                if (FOLD_A) asm volatile("" : "+v"(t[0][0]), "+v"(t[0][1]), "+v"(t[0][2]), "+v"(t[0][3]), "+v"(t[1][0]), "+v"(t[1][1]), "+v"(t[1][2]), "+v"(t[1][3]),
                                  "+v"(st[0][0]), "+v"(st[0][1]), "+v"(st[0][2]), "+v"(st[0][3]), "+v"(st[1][0]), "+v"(st[1][1]), "+v"(st[1][2]), "+v"(st[1][3]));
                else pin8f(t[0][0], t[0][1], t[0][2], t[0][3], t[1][0], t[1][1], t[1][2], t[1][3]);
#pragma unroll
                for (int bj = 0; bj < 2; ++bj)
#pragma unroll
                    for (int e = 0; e < 4; ++e) { cu[bj][e] = t[bj][0][e]; cu[bj][4 + e] = t[bj][1][e]; cv[bj][e] = t[bj][2][e]; cv[bj][4 + e] = t[bj][3][e]; }
            }
        }
#pragma unroll
        for (int ai = 0; ai < 2; ++ai) {
            u32x4 xw[4][2];
            if (RES || GATE) {
#pragma unroll
                for (int m = 0; m < 4; ++m)
#pragma unroll
                    for (int bj = 0; bj < 2; ++bj) { const size_t r = (size_t)(row0 + ai * 128 + m * 16);
                        xw[m][bj] = RES ? *(const u32x4*)(G + r * DM + col0 + bj * 128) : *(const u32x4*)(G + r * 4096 + gofs + col0 + bj * 128); }
            }
            f32x2 sr[4] = {{0.f, 0.f}, {0.f, 0.f}, {0.f, 0.f}, {0.f, 0.f}};
            if (RES) { if (fold) {
#pragma unroll
                for (int m = 0; m < 4; ++m) sr[m] = *(const f32x2*)(f.stats + 2 * (size_t)(row0 + ai * 128 + m * 16));
                asm volatile("" : "+v"(sr[0]), "+v"(sr[1]), "+v"(sr[2]), "+v"(sr[3])); } }
            if (RES || GATE) pin8(xw[0][0], xw[0][1], xw[1][0], xw[1][1], xw[2][0], xw[2][1], xw[3][0], xw[3][1]);
#pragma unroll
            for (int m = 0; m < 4; ++m) {
                const size_t r = (size_t)(row0 + ai * 128 + m * 16);
                bf16_t* rowp = base + r * ld + col0;
                float mean = 0.f, rstd = 1.f;
                if ((FOLD_A || RES) && fold) { const f32x2 sq = RES ? sr[m] : st[ai][m]; mean = sq.x * (1.0f / DM); rstd = rsqrtf(fmaxf(sq.y * (1.0f / DM) - mean * mean, 0.f) + LN_EPS); }
                float ssum = 0.f, ssq = 0.f;
#pragma unroll
                for (int bj = 0; bj < 2; ++bj) {
                    float v[8] = {acc[ai][bj][m][0][0], acc[ai][bj][m][0][1], acc[ai][bj][m][0][2], acc[ai][bj][m][0][3], acc[ai][bj][m][1][0], acc[ai][bj][m][1][1], acc[ai][bj][m][1][2], acc[ai][bj][m][1][3]};
                    if (FOLD_A) { if (fold) {
#pragma unroll
                        for (int e = 0; e < 8; ++e) v[e] = rstd * (v[e] - mean * cu[bj][e]) + cv[bj][e]; } }
                    if (MODE == 0) { if (sig) {
#pragma unroll
                        for (int e = 0; e < 8; ++e) v[e] = __builtin_amdgcn_rcpf(1.0f + __expf(-v[e])); } }
                    if (GATE) { const u32x4 gw = xw[m][bj];
                        v[0] *= bf_lo(gw.x); v[1] *= bf_hi(gw.x); v[2] *= bf_lo(gw.y); v[3] *= bf_hi(gw.y); v[4] *= bf_lo(gw.z); v[5] *= bf_hi(gw.z); v[6] *= bf_lo(gw.w); v[7] *= bf_hi(gw.w); }
                    if (MODE == 2) {
                        const u32x4 ow = *(const u32x4*)(rowp + bj * 128);
                        v[0] += bf_lo(ow.x); v[1] += bf_hi(ow.x); v[2] += bf_lo(ow.y); v[3] += bf_hi(ow.y); v[4] += bf_lo(ow.z); v[5] += bf_hi(ow.z); v[6] += bf_lo(ow.w); v[7] += bf_hi(ow.w); }
                    if (RES) { const u32x4 hw = xw[m][bj];
                        const float h[8] = {bf_lo(hw.x), bf_hi(hw.x), bf_lo(hw.y), bf_hi(hw.y), bf_lo(hw.z), bf_hi(hw.z), bf_lo(hw.w), bf_hi(hw.w)};
#pragma unroll
                        for (int e = 0; e < 8; ++e) { const float hh = fold ? ((h[e] - mean) * rstd * cu[bj][e] + cv[bj][e]) : h[e]; v[e] += ALPHA_F * hh; ssum += v[e]; ssq += v[e] * v[e]; } }
                    if (MODE == 4) {
#pragma unroll
                        for (int e = 0; e < 8; ++e) { const float a = fmaxf(v[e], 0.f); v[e] = a * a; } }
                    u32x4 w; w.x = pk_bf16(v[0], v[1]); w.y = pk_bf16(v[2], v[3]); w.z = pk_bf16(v[4], v[5]); w.w = pk_bf16(v[6], v[7]);
                    *(u32x4*)(rowp + bj * 128) = w; }
                if (RES) { if (stats_out != nullptr) {
                    ssum += __shfl_xor(ssum, 16); ssum += __shfl_xor(ssum, 32); ssq += __shfl_xor(ssq, 16); ssq += __shfl_xor(ssq, 32);
                    if (fq == 0) { atomicAdd(stats_out + 2 * r, ssum); atomicAdd(stats_out + 2 * r + 1, ssq); } } }
            }
        }
    }
};

template <int MODE>
__device__ __forceinline__ void run_gemm(unsigned char* lds, const bf16_t* A, const bf16_t* Bt, int N, int K, const EpiX<MODE>& E, const bf16_t* A2 = nullptr, const bf16_t* Bt2 = nullptr) {
    pg8::Gemm g{A, Bt, NTOK, N, K, A2, Bt2}; pg8::StaticOrder S; S.init(NTOK, N, NBLK(), BID());
    pg8::gemm_phase<EpiX<MODE>, pg8::StaticOrder, MODE == 6>((PG8_LAS unsigned char*)lds, g, S, E);
}

struct CvtJob { const float* src; bf16_t* dst; int K, N, tk, tn; };
__device__ __forceinline__ CvtJob cvt_plain_job(const Params& p, int layer, int id) {
    CvtJob j; int loc; unsigned char* ws = p.ws;
    if (id < 512)        { loc = id;         j.K = HYW; j.N = DM;  j.src = p.in[15] + (size_t)layer * HYW * DM;  j.dst = (bf16_t*)(ws + WS_WHY); }
    else if (id < 1024)  { loc = id - 512;   j.K = QW;  j.N = DM;  j.src = p.in[16] + (size_t)layer * QW * DM;   j.dst = (bf16_t*)(ws + WS_WAT); }
    else if (id < 2048)  { loc = id - 1024;  j.K = DM;  j.N = DM;  j.src = p.in[17] + (size_t)layer * DM * DM;   j.dst = (bf16_t*)(ws + WS_WO); }
    else                 { loc = id - 2048;  j.K = DFF; j.N = DM;  j.src = p.in[21] + (size_t)layer * DFF * DM;  j.dst = (bf16_t*)(ws + WS_WDN); }
    const int ntn = j.N >> 6; j.tk = loc / ntn; j.tn = loc - j.tk * ntn; return j;
}
__device__ __forceinline__ void convert_weights_phase(int layer, unsigned char* lds) {
    const Params p = get_params(); const int bid = BID(), nblk = NBLK();
    LAS float* tile = (LAS float*)lds; const int tid = TID();
    constexpr int TS = 64 * 65, NS_IN = 136, NS = 264, NPLAIN = 768;
    const bool bal = (nblk == 256);
    const int nstrip_mine = bal ? (bid < 8 ? 2 : 1) : (NS - bid + nblk - 1) / nblk;
    const int plain0 = bal ? bid - 8 : bid, pstep = bal ? 248 : nblk;
    const int nplain_mine = (bal && bid < 8) ? 0 : (plain0 < NPLAIN ? (NPLAIN - plain0 + pstep - 1) / pstep : 0);
    const int nsteps = nstrip_mine * 4 + nplain_mine;
    float pu = 0.f, pv = 0.f;
    for (int st = 0; st < nsteps; ++st) {
        const bool strip = st < nstrip_mine * 4;
        const int sidx = bal ? bid + 256 * (st >> 2) : bid + nblk * (st >> 2), sq = st & 3;
        const bool is_in = sidx < NS_IN; const int stn = is_in ? sidx : sidx - NS_IN;
        CvtJob sj; sj.K = DM; sj.N = is_in ? NIN : DFF; sj.tn = stn; sj.tk = sq * 8;
        sj.src = is_in ? p.in[3] + (size_t)layer * DM * NIN : p.in[20] + (size_t)layer * DM * DFF; sj.dst = (bf16_t*)(p.ws + (is_in ? WS_WIN : WS_WUP));
        const float* fg = is_in ? (layer > 0 ? p.in[22] + (size_t)(layer - 1) * DM : nullptr) : p.in[18] + (size_t)layer * DM;
        const float* fb = is_in ? (layer > 0 ? p.in[23] + (size_t)(layer - 1) * DM : nullptr) : p.in[19] + (size_t)layer * DM;
        const int pbase = (plain0 + pstep * (st - nstrip_mine * 4)) * 8;
        f32x4 a[8], b[8];
#pragma unroll
        for (int q = 0; q < 8; ++q) { CvtJob j = sj; if (strip) j.tk = sj.tk + q; else j = cvt_plain_job(p, layer, pbase + q);
            const int kk = tid >> 3, n8 = (tid & 7) * 8; const float* s = j.src + (size_t)(j.tk * 64 + kk) * j.N + j.tn * 64 + n8;
            a[q] = __builtin_nontemporal_load((const f32x4*)s); b[q] = __builtin_nontemporal_load((const f32x4*)(s + 4)); }
        LAS float* gbs = tile + 8 * TS;
        if (strip && sq == 0 && fg != nullptr) { const f32x4 gq = *(const f32x4*)(fg + tid * 4), bq = *(const f32x4*)(fb + tid * 4); *(LAS f32x4*)(gbs + tid * 4) = gq; *(LAS f32x4*)(gbs + DM + tid * 4) = bq; }
#pragma unroll
        for (int q = 0; q < 8; ++q) { const int kk = tid >> 3, n8 = (tid & 7) * 8;
            LAS float* d = tile + q * TS + kk * 65 + n8; d[0] = a[q][0]; d[1] = a[q][1]; d[2] = a[q][2]; d[3] = a[q][3]; d[4] = b[q][0]; d[5] = b[q][1]; d[6] = b[q][2]; d[7] = b[q][3]; }
        __syncthreads();
        if (strip && sq == 0) { pu = 0.f; pv = 0.f; }
#pragma unroll
        for (int q = 0; q < 8; ++q) { CvtJob j = sj; if (strip) j.tk = sj.tk + q; else j = cvt_plain_job(p, layer, pbase + q);
            const int n = tid >> 3, k8 = (tid & 7) * 8; float v[8];
#pragma unroll
            for (int e = 0; e < 8; ++e) v[e] = tile[q * TS + (k8 + e) * 65 + n];
            if (strip) { const int k0 = j.tk * 64 + k8;
                if (fg != nullptr) { const f32x4 g0 = *(const LAS f32x4*)(gbs + k0), g1 = *(const LAS f32x4*)(gbs + k0 + 4), b0 = *(const LAS f32x4*)(gbs + DM + k0), b1 = *(const LAS f32x4*)(gbs + DM + k0 + 4);
#pragma unroll
                    for (int e = 0; e < 4; ++e) { pv += b0[e] * v[e] + b1[e] * v[4 + e]; v[e] *= g0[e]; v[4 + e] *= g1[e]; } } }
            u32x4 w; w.x = pk_bf16(v[0], v[1]); w.y = pk_bf16(v[2], v[3]); w.z = pk_bf16(v[4], v[5]); w.w = pk_bf16(v[6], v[7]);
            if (strip) pu += ((bf_lo(w.x) + bf_hi(w.x)) + (bf_lo(w.y) + bf_hi(w.y))) + ((bf_lo(w.z) + bf_hi(w.z)) + (bf_lo(w.w) + bf_hi(w.w)));
            *(u32x4*)(j.dst + (size_t)(j.tn * 64 + n) * j.K + j.tk * 64 + k8) = w; }
        if (strip && sq == 3) {
            float ru = pu, rv = pv;
            ru += __shfl_xor(ru, 1); ru += __shfl_xor(ru, 2); ru += __shfl_xor(ru, 4); rv += __shfl_xor(rv, 1); rv += __shfl_xor(rv, 2); rv += __shfl_xor(rv, 4);
            if ((tid & 7) == 0) { const int n = stn * 64 + (tid >> 3); ((float*)(p.ws + (is_in ? WS_PUIN : WS_PUUP)))[n] = ru; ((float*)(p.ws + (is_in ? WS_PVIN : WS_PVUP)))[n] = rv; } }
        __syncthreads();
    }
}

template <int MODE>
__device__ __forceinline__ void ln_row_load(const Params& p, const bf16_t* rsrc, int row, int lane, float (&v)[32]) {
    if (MODE == 0) {
#pragma unroll
        for (int k = 0; k < 8; ++k) { const f32x4 x = *(const f32x4*)(p.in[0] + (size_t)row * DM + (k * 64 + lane) * 4); v[4 * k] = x[0]; v[4 * k + 1] = x[1]; v[4 * k + 2] = x[2]; v[4 * k + 3] = x[3]; }
    } else {
#pragma unroll
        for (int k = 0; k < 4; ++k) { const u32x4 w = *(const u32x4*)(rsrc + (size_t)row * DM + (k * 64 + lane) * 8);
            v[8 * k] = bf_lo(w.x); v[8 * k + 1] = bf_hi(w.x); v[8 * k + 2] = bf_lo(w.y); v[8 * k + 3] = bf_hi(w.y); v[8 * k + 4] = bf_lo(w.z); v[8 * k + 5] = bf_hi(w.z); v[8 * k + 6] = bf_lo(w.w); v[8 * k + 7] = bf_hi(w.w); }
    }
}
template <int MODE>
__device__ __forceinline__ void ln_load_gb(const float* g, const float* b, int lane, float (&gg)[32], float (&bb)[32]) {
    f32x4 tg[8], tb[8];
#pragma unroll
    for (int k = 0; k < 8; ++k) { const int c = MODE == 0 ? (k * 64 + lane) * 4 : ((k >> 1) * 64 + lane) * 8 + (k & 1) * 4; tg[k] = *(const f32x4*)(g + c); tb[k] = *(const f32x4*)(b + c); }
    pin8f(tg[0], tg[1], tg[2], tg[3], tg[4], tg[5], tg[6], tg[7]); pin8f(tb[0], tb[1], tb[2], tb[3], tb[4], tb[5], tb[6], tb[7]);
#pragma unroll
    for (int k = 0; k < 8; ++k)
#pragma unroll
        for (int e = 0; e < 4; ++e) { gg[4 * k + e] = tg[k][e]; bb[4 * k + e] = tb[k][e]; }
}
template <int MODE>
__device__ __forceinline__ void ln_row_finish(const Params& p, const float (&gg)[32], const float (&bb)[32], bf16_t* hb, int row, int lane, const float (&v)[32]) {
    float sum = 0.f;
#pragma unroll
    for (int e = 0; e < 32; ++e) sum += v[e];
#pragma unroll
    for (int o = 32; o > 0; o >>= 1) sum += __shfl_xor(sum, o);
    const float mean = sum * (1.0f / DM);
    float q = 0.f;
#pragma unroll
    for (int e = 0; e < 32; ++e) { const float d = v[e] - mean; q += d * d; }
#pragma unroll
    for (int o = 32; o > 0; o >>= 1) q += __shfl_xor(q, o);
    const float rstd = rsqrtf(q * (1.0f / DM) + LN_EPS);
    float o[32];
#pragma unroll
    for (int e = 0; e < 32; ++e) o[e] = (v[e] - mean) * rstd * gg[e] + bb[e];
    if (MODE == 0) {
#pragma unroll
        for (int k = 0; k < 8; ++k) { const int c = (k * 64 + lane) * 4; u32x2 w; w.x = pk_bf16(o[4 * k], o[4 * k + 1]); w.y = pk_bf16(o[4 * k + 2], o[4 * k + 3]); *(u32x2*)(hb + (size_t)row * DM + c) = w; }
    } else {
#pragma unroll
        for (int k = 0; k < 4; ++k) { const int c = (k * 64 + lane) * 8;
            if (MODE == 1) { u32x4 w; w.x = pk_bf16(o[8 * k], o[8 * k + 1]); w.y = pk_bf16(o[8 * k + 2], o[8 * k + 3]); w.z = pk_bf16(o[8 * k + 4], o[8 * k + 5]); w.w = pk_bf16(o[8 * k + 6], o[8 * k + 7]); *(u32x4*)(hb + (size_t)row * DM + c) = w; }
            else { *(f32x4*)(p.out + (size_t)row * DM + c) = (f32x4){o[8 * k], o[8 * k + 1], o[8 * k + 2], o[8 * k + 3]}; *(f32x4*)(p.out + (size_t)row * DM + c + 4) = (f32x4){o[8 * k + 4], o[8 * k + 5], o[8 * k + 6], o[8 * k + 7]}; } }
    }
}
template <int MODE>
__device__ __forceinline__ void ln_phase(int gi, int bi, int layer) {
    const Params p = get_params(); const int bid = BID(), nblk = NBLK();
    const float* g = p.in[gi] + layer * DM; const float* b = p.in[bi] + layer * DM; bf16_t* hb = (bf16_t*)(p.ws + WS_HB);
    const bf16_t* rsrc = (const bf16_t*)(p.ws + WS_HB);
    const int tid = TID(), wid = tid >> 6, lane = tid & 63; const int rstride = nblk * 8;
    float gg[32], bb[32]; ln_load_gb<MODE>(g, b, lane, gg, bb);
    for (int row = bid * 8 + wid; row < NTOK; row += 2 * rstride) {
        float v0[32], v1[32]; const int row1 = row + rstride;
        ln_row_load<MODE>(p, rsrc, row, lane, v0);
        if (row1 < NTOK) ln_row_load<MODE>(p, rsrc, row1, lane, v1);
        ln_row_finish<MODE>(p, gg, bb, hb, row, lane, v0);
        if (row1 < NTOK) ln_row_finish<MODE>(p, gg, bb, hb, row1, lane, v1);
    }
}

__device__ __forceinline__ void hdn_phase(unsigned char* lds) {
    const Params p = get_params(); const int bid = BID(), nblk = NBLK();
    LAS float* feats = (LAS float*)lds;
    LAS float* h1 = feats + 64 * 33;
    const int tid = TID(); float* HDN = (float*)(p.ws + WS_HDN);
    { f32x2* TAB = (f32x2*)(p.ws + WS_ROPE);
      for (int i = bid * NTHR + tid; i < 128 * 32; i += nblk * NTHR) { const int pos = i >> 5, ii = i & 31;
          const float inv = exp2f(-(float)ii * (13.287712379549449f / 32.0f)); float sn, cs; sincosf((float)pos * inv, &sn, &cs); TAB[i] = (f32x2){cs, sn}; } }
    for (int it = bid; it < DEPTH * (SEQL / 64); it += nblk) {
        const int layer = it / (SEQL / 64), t0 = (it - layer * (SEQL / 64)) * 64;
        const float* w1 = p.in[6] + layer * FEMB * FHID; const float* b1 = p.in[7] + layer * FHID;
        const float* w2 = p.in[8] + layer * FHID * FHID; const float* b2 = p.in[9] + layer * FHID; const float* fr = p.in[11] + layer * FHID;
        __syncthreads();
#pragma unroll
        for (int q = 0; q < 2; ++q) { const int idx = q * NTHR + tid, tt = idx >> 4, bnd = idx & 15, pos = t0 + tt;
            const float wv = 6.283185307179586f * (float)pos / (float)SEQL; const float fb = 1e-4f + (float)bnd * ((15.0f - 1e-4f) / 15.0f);
            float sn, cs; sincosf(wv * fb, &sn, &cs); feats[tt * 33 + 1 + bnd] = cs; feats[tt * 33 + 17 + bnd] = -sn;
            if (bnd == 0) feats[tt * 33] = (float)pos / (float)(SEQL - 1); }
        __syncthreads();
        const int tt = tid >> 3, j8 = (tid & 7) * 8;
        { f32x4 a0 = *(const f32x4*)(b1 + j8), a1 = *(const f32x4*)(b1 + j8 + 4);
#pragma unroll 3
          for (int i = 0; i < FEMB; ++i) { const float f = feats[tt * 33 + i]; a0 += f * *(const f32x4*)(w1 + i * FHID + j8); a1 += f * *(const f32x4*)(w1 + i * FHID + j8 + 4); }
          const f32x4 f0 = *(const f32x4*)(fr + j8), f1 = *(const f32x4*)(fr + j8 + 4);
#pragma unroll
          for (int e = 0; e < 4; ++e) { h1[tt * 65 + j8 + e] = sinf(f0[e] * a0[e]); h1[tt * 65 + j8 + 4 + e] = sinf(f1[e] * a1[e]); } }
        __syncthreads();
        { f32x4 a0 = *(const f32x4*)(b2 + j8), a1 = *(const f32x4*)(b2 + j8 + 4);
#pragma unroll 4
          for (int i = 0; i < FHID; ++i) { const float f = h1[tt * 65 + i]; a0 += f * *(const f32x4*)(w2 + i * FHID + j8); a1 += f * *(const f32x4*)(w2 + i * FHID + j8 + 4); }
          const f32x4 f0 = *(const f32x4*)(fr + j8), f1 = *(const f32x4*)(fr + j8 + 4);
          f32x4 o0, o1;
#pragma unroll
          for (int e = 0; e < 4; ++e) { o0[e] = sinf(f0[e] * a0[e]); o1[e] = sinf(f1[e] * a1[e]); }
          float* dst = HDN + ((size_t)layer * SEQL + t0 + tt) * FHID + j8; *(f32x4*)dst = o0; *(f32x4*)(dst + 4) = o1; }
    }
}

__device__ __forceinline__ void hyena_pre_phase(int layer, unsigned char* lds) {
    const Params p = get_params(); const int bid = BID(), nblk = NBLK();
    LAS float* zs = (LAS float*)lds; constexpr int TS = 2 * 64 * 65;
    const int tid = TID();
    const bf16_t* PH = (const bf16_t*)(p.ws + WS_PH); float* Z = (float*)(p.ws + WS_Z); bf16_t* X0T = (bf16_t*)(p.ws + WS_X0T);
    const float* cw = p.in[4] + (size_t)layer * 3 * 3072; const float* cb = p.in[5] + (size_t)layer * 3072;
    for (int tile0 = bid; tile0 < 4096; tile0 += 2 * nblk) {
        u32x4 xr[2][3][3];
#pragma unroll
        for (int u = 0; u < 2; ++u) { const int tile = tile0 + u * nblk; if (tile < 4096) {
            const int t0 = (tile >> 4) * 64, c0 = (tile & 15) * 64, tt = tid >> 3, cg8 = (tid & 7) * 8, t = t0 + tt, tl = t & (SEQL - 1);
#pragma unroll
            for (int g = 0; g < 3; ++g) { const bf16_t* pr = PH + (size_t)t * 3072 + g * 1024 + c0 + cg8; const u32x4 z4 = {0u, 0u, 0u, 0u};
                xr[u][g][0] = tl > 0 ? *(const u32x4*)(pr - 3072) : z4; xr[u][g][1] = *(const u32x4*)pr; xr[u][g][2] = tl < SEQL - 1 ? *(const u32x4*)(pr + 3072) : z4; } } }
        __syncthreads();
#pragma unroll
        for (int u = 0; u < 2; ++u) { const int tile = tile0 + u * nblk; if (tile < 4096) {
            const int c0 = (tile & 15) * 64, tt = tid >> 3, cg8 = (tid & 7) * 8;
            float o[3][8];
#pragma unroll
            for (int g = 0; g < 3; ++g) {
                const int ch = g * 1024 + c0 + cg8; const u32x4 xm = xr[u][g][0], xc = xr[u][g][1], xp = xr[u][g][2];
                const f32x4 w0a = *(const f32x4*)(cw + ch), w0b = *(const f32x4*)(cw + ch + 4);
                const f32x4 w1a = *(const f32x4*)(cw + 3072 + ch), w1b = *(const f32x4*)(cw + 3072 + ch + 4);
                const f32x4 w2a = *(const f32x4*)(cw + 6144 + ch), w2b = *(const f32x4*)(cw + 6144 + ch + 4);
                const f32x4 ba = *(const f32x4*)(cb + ch), bb = *(const f32x4*)(cb + ch + 4);
                o[g][0] = bf_lo(xm.x) * w0a[0] + bf_lo(xc.x) * w1a[0] + bf_lo(xp.x) * w2a[0] + ba[0];
                o[g][1] = bf_hi(xm.x) * w0a[1] + bf_hi(xc.x) * w1a[1] + bf_hi(xp.x) * w2a[1] + ba[1];
                o[g][2] = bf_lo(xm.y) * w0a[2] + bf_lo(xc.y) * w1a[2] + bf_lo(xp.y) * w2a[2] + ba[2];
                o[g][3] = bf_hi(xm.y) * w0a[3] + bf_hi(xc.y) * w1a[3] + bf_hi(xp.y) * w2a[3] + ba[3];
                o[g][4] = bf_lo(xm.z) * w0b[0] + bf_lo(xc.z) * w1b[0] + bf_lo(xp.z) * w2b[0] + bb[0];
                o[g][5] = bf_hi(xm.z) * w0b[1] + bf_hi(xc.z) * w1b[1] + bf_hi(xp.z) * w2b[1] + bb[1];
                o[g][6] = bf_lo(xm.w) * w0b[2] + bf_lo(xc.w) * w1b[2] + bf_lo(xp.w) * w2b[2] + bb[2];
                o[g][7] = bf_hi(xm.w) * w0b[3] + bf_hi(xc.w) * w1b[3] + bf_hi(xp.w) * w2b[3] + bb[3];
            }
            LAS float* zt = zs + u * TS; LAS float* xt = zt + 64 * 65;
#pragma unroll
            for (int e = 0; e < 8; ++e) { zt[(cg8 + e) * 65 + tt] = o[2][e] * o[1][e]; xt[(cg8 + e) * 65 + tt] = o[0][e]; } } }
        __syncthreads();
#pragma unroll
        for (int u = 0; u < 2; ++u) { const int tile = tile0 + u * nblk; if (tile < 4096) {
            const int t0 = (tile >> 4) * 64, c0 = (tile & 15) * 64;
            const int c = tid >> 3, tq = (tid & 7) * 8; const int bidx = t0 >> 13, tl0 = t0 & (SEQL - 1);
            const LAS float* zt = zs + u * TS; const LAS float* xt = zt + 64 * 65;
            float zv[8], xv[8];
#pragma unroll
            for (int e = 0; e < 8; ++e) { zv[e] = zt[c * 65 + tq + e]; xv[e] = xt[c * 65 + tq + e]; }
            const size_t off = ((size_t)(c0 + c) * 2 + bidx) * SEQL + tl0 + tq;
            *(f32x4*)(Z + off) = (f32x4){zv[0], zv[1], zv[2], zv[3]}; *(f32x4*)(Z + off + 4) = (f32x4){zv[4], zv[5], zv[6], zv[7]};
            u32x4 w; w.x = pk_bf16(xv[0], xv[1]); w.y = pk_bf16(xv[2], xv[3]); w.z = pk_bf16(xv[4], xv[5]); w.w = pk_bf16(xv[6], xv[7]);
            *(u32x4*)(X0T + off) = w; } }
    }
}

__device__ __forceinline__ void qk_rope_phase(int layer) {
    const Params p = get_params(); const int bid = BID(), nblk = NBLK();
    const int tid = TID(), sub = tid & 15;
    bf16_t* QKV = (bf16_t*)(p.ws + WS_QKV);
    const float* qn = p.in[13] + layer * HD; const float* kn = p.in[14] + layer * HD;
    const int vstride = nblk * 32;
    for (int vi0 = bid * 32 + (tid >> 4); vi0 < NTOK * 10; vi0 += 4 * vstride) {
        u32x4 w[4]; f32x4 tb[4][4]; f32x4 ga[4], gb[4];
#pragma unroll
        for (int u = 0; u < 4; ++u) { const int vi = vi0 + u * vstride; if (vi < NTOK * 10) {
            const int t = vi / 10, hh = vi - t * 10, tl = t & (SEQL - 1);
            w[u] = *(const u32x4*)(QKV + (size_t)t * 1536 + hh * HD + sub * 8);
            const int pos = (sub >> 3) == 0 ? (tl >> 6) : (tl & 63);
            const f32x4* tp = (const f32x4*)(p.ws + WS_ROPE) + (pos * 32 + (sub & 3) * 8) / 2;
#pragma unroll
            for (int e2 = 0; e2 < 4; ++e2) tb[u][e2] = tp[e2];
            const float* gp = (hh < 8 ? qn : kn) + sub * 8; ga[u] = *(const f32x4*)gp; gb[u] = *(const f32x4*)(gp + 4); } }
#pragma unroll
        for (int u = 0; u < 4; ++u) { const int vi = vi0 + u * vstride; if (vi < NTOK * 10) {
            const int t = vi / 10, hh = vi - t * 10;
            float x[8] = {bf_lo(w[u].x), bf_hi(w[u].x), bf_lo(w[u].y), bf_hi(w[u].y), bf_lo(w[u].z), bf_hi(w[u].z), bf_lo(w[u].w), bf_hi(w[u].w)};
            float ss = 0.f;
#pragma unroll
            for (int e = 0; e < 8; ++e) ss += x[e] * x[e];
            ss += __shfl_xor(ss, 1); ss += __shfl_xor(ss, 2); ss += __shfl_xor(ss, 4); ss += __shfl_xor(ss, 8);
            const float rs = rsqrtf(ss * (1.0f / HD) + RMS_EPS);
            x[0] *= rs * ga[u][0]; x[1] *= rs * ga[u][1]; x[2] *= rs * ga[u][2]; x[3] *= rs * ga[u][3]; x[4] *= rs * gb[u][0]; x[5] *= rs * gb[u][1]; x[6] *= rs * gb[u][2]; x[7] *= rs * gb[u][3];
            const bool hi_half = ((sub >> 2) & 1) != 0;
            float y[8];
#pragma unroll
            for (int e2 = 0; e2 < 4; ++e2) {
                const f32x4 cs = tb[u][e2];
                const float o0 = __shfl_xor(x[2 * e2], 4), o1 = __shfl_xor(x[2 * e2 + 1], 4);
                y[2 * e2]     = hi_half ? (x[2 * e2] * cs[0] + o0 * cs[1]) : (x[2 * e2] * cs[0] - o0 * cs[1]);
                y[2 * e2 + 1] = hi_half ? (x[2 * e2 + 1] * cs[2] + o1 * cs[3]) : (x[2 * e2 + 1] * cs[2] - o1 * cs[3]);
            }
            u32x4 o; o.x = pk_bf16(y[0], y[1]); o.y = pk_bf16(y[2], y[3]); o.z = pk_bf16(y[4], y[5]); o.w = pk_bf16(y[6], y[7]);
            *(u32x4*)(QKV + (size_t)t * 1536 + hh * HD + sub * 8) = o; } }
    }
}

__device__ __forceinline__ int fpad(int i) { return i + (i >> 4); }
__device__ __forceinline__ f32x2 cmul(f32x2 a, f32x2 b) { return (f32x2){a.x * b.x - a.y * b.y, a.x * b.y + a.y * b.x}; }
__device__ __forceinline__ constexpr float c16(int k) { return k == 0 ? 1.0f : k == 1 ? 0.9238795325112867f : k == 2 ? 0.7071067811865476f : k == 3 ? 0.3826834323650898f : k == 4 ? 0.0f : k == 5 ? -0.3826834323650898f : k == 6 ? -0.7071067811865476f : -0.9238795325112867f; }
__device__ __forceinline__ constexpr float s16(int k) { return k == 0 ? 0.0f : k == 1 ? 0.3826834323650898f : k == 2 ? 0.7071067811865476f : k == 3 ? 0.9238795325112867f : k == 4 ? 1.0f : k == 5 ? 0.9238795325112867f : k == 6 ? 0.7071067811865476f : 0.3826834323650898f; }

template <int LOGR, int SLOG, bool INV, bool HALF_IN = false, bool HALF_OUT = false>
__device__ __forceinline__ void fft_pass(LAS f32x2* X, int tid_in, const LAS f32x2* TW) {
    constexpr int R = 1 << LOGR, STRIDE = 1 << SLOG, NIT = FFTN / R, PER = (LOGR == 4 ? 1 : 2);
    const int tid = lv(tid_in);
#pragma unroll 1
    for (int w0 = tid; w0 < NIT; w0 += PER * NTHR) {
#pragma unroll
      for (int u = 0; u < PER; ++u) {
        const int w = w0 + u * NTHR;
        const int r = w & (STRIDE - 1), i0 = ((w >> SLOG) << (SLOG + LOGR)) + r;
        f32x2 v[R];
#pragma unroll
        for (int j = 0; j < (HALF_IN ? R / 2 : R); ++j) v[j] = X[fpad(i0 + j * STRIDE)];
        f32x2 wp[LOGR];
        if (SLOG == 0) {
#pragma unroll
            for (int s = 0; s < LOGR; ++s) wp[s] = (f32x2){1.0f, 0.0f};
        } else {
            const f32x2 t0 = TW[r]; wp[0] = INV ? (f32x2){t0.x, -t0.y} : t0;
#pragma unroll
            for (int s = 1; s < LOGR; ++s) wp[s] = cmul(wp[s - 1], wp[s - 1]);
        }
        if (!INV) {
#pragma unroll
            for (int s = 0; s < LOGR; ++s) {
                const int half = R >> (s + 1);
#pragma unroll
                for (int j = 0; j < R; ++j) if ((j & half) == 0) {
                    const int jl = j & (half - 1), idx = jl * (8 / half);
                    f32x2 d;
                    if (HALF_IN && s == 0) { d = v[j]; }
                    else { const f32x2 a = v[j], b = v[j + half]; v[j] = a + b; d = a - b; }
                    if (SLOG == 0) { v[j + half] = idx == 0 ? d : cmul(d, (f32x2){c16(idx), -s16(idx)}); }
                    else { const f32x2 t = idx == 0 ? wp[s] : cmul(wp[s], (f32x2){c16(idx), -s16(idx)}); v[j + half] = cmul(d, t); } }
            }
        } else {
#pragma unroll
            for (int s = LOGR - 1; s >= 0; --s) {
                const int half = R >> (s + 1);
#pragma unroll
                for (int j = 0; j < R; ++j) if ((j & half) == 0) {
                    const int jl = j & (half - 1), idx = jl * (8 / half);
                    f32x2 b;
                    if (SLOG == 0) { b = idx == 0 ? v[j + half] : cmul(v[j + half], (f32x2){c16(idx), s16(idx)}); }
                    else { const f32x2 t = idx == 0 ? wp[s] : cmul(wp[s], (f32x2){c16(idx), s16(idx)}); b = cmul(v[j + half], t); }
                    const f32x2 a = v[j]; v[j] = a + b; if (!(HALF_OUT && s == 0)) v[j + half] = a - b; }
            }
        }
#pragma unroll
        for (int j = 0; j < (HALF_OUT ? R / 2 : R); ++j) X[fpad(i0 + j * STRIDE)] = v[j];
      }
    }
}
constexpr int TW_A = 0, TW_B = 1024, TW_C = 1024 + 128, TW_N = 1024 + 128 + 16;
__device__ __forceinline__ void fft_build_twiddles(LAS f32x2* TW, int tid) {
    for (int i = tid; i < TW_N; i += NTHR) {
        const int r = i < TW_B ? i : (i < TW_C ? i - TW_B : i - TW_C); const float den = i < TW_B ? (1.0f / 16384.0f) : (i < TW_C ? (1.0f / 1024.0f) : (1.0f / 128.0f));
        float sn, cs; sincospif(-2.0f * (float)r * den, &sn, &cs); TW[i] = (f32x2){cs, sn}; }
}
template <bool HALF_IN>
__device__ __forceinline__ void fft_fwd(LAS f32x2* X, int tid, const LAS f32x2* TW) {
    fft_pass<4, 10, false, HALF_IN>(X, tid, TW + TW_A); __syncthreads(); fft_pass<3, 7, false>(X, tid, TW + TW_B); __syncthreads(); fft_pass<3, 4, false>(X, tid, TW + TW_C); __syncthreads(); fft_pass<4, 0, false>(X, tid, TW); __syncthreads();
}
__device__ __forceinline__ void fft_inv_half(LAS f32x2* X, int tid, const LAS f32x2* TW) {
    fft_pass<4, 0, true>(X, tid, TW); __syncthreads(); fft_pass<3, 4, true>(X, tid, TW + TW_C); __syncthreads(); fft_pass<3, 7, true>(X, tid, TW + TW_B); __syncthreads(); fft_pass<4, 10, true, false, true>(X, tid, TW + TW_A); __syncthreads();
}

constexpr int KT_EARLY = 1280;
template <int PART>
__device__ __forceinline__ void ktime_phase(int layer, unsigned char* lds) {
    const Params p = get_params(); const int bid = BID(), nblk = NBLK(); const int tid = TID();
    LAS float* hT = (LAS float*)lds;
    LAS float* wT = hT + 64 * 132;
    const float* hdn = (const float*)(p.ws + WS_HDN) + (size_t)layer * SEQL * FHID;
    const float* w3 = p.in[10] + (size_t)layer * FHID * 2 * HYW; float* KT = p.out;
    const bool split = (nblk == 256);
    if (PART == 1 && (!split || bid < 128)) return;
    const int first = PART == 1 ? bid - 128 : (PART == 2 && split ? KT_EARLY + bid : bid), step = PART == 1 ? 128 : nblk, lim = PART == 1 ? KT_EARLY : 64 * 32;
    for (int tile = first; tile < lim; tile += step) {
        const int t0 = (tile >> 5) * 128, col0 = (tile & 31) * 64;
        __syncthreads();
        { f32x4 hq[4], wq[2];
#pragma unroll
          for (int q = 0; q < 4; ++q) { const int idx = q * NTHR + tid, tt = idx >> 4, j4 = (idx & 15) * 4;
              hq[q] = *(const f32x4*)(hdn + (size_t)(t0 + tt) * FHID + j4); }
#pragma unroll
          for (int q = 0; q < 2; ++q) { const int idx = q * NTHR + tid, j = idx >> 4, c4 = (idx & 15) * 4; wq[q] = *(const f32x4*)(w3 + (size_t)j * (2 * HYW) + col0 + c4); }
          asm volatile("" : "+v"(hq[0]), "+v"(hq[1]), "+v"(hq[2]), "+v"(hq[3]), "+v"(wq[0]), "+v"(wq[1]));
#pragma unroll
          for (int q = 0; q < 4; ++q) { const int idx = q * NTHR + tid, tt = idx >> 4, j4 = (idx & 15) * 4;
              hT[(j4 + 0) * 132 + tt] = hq[q][0]; hT[(j4 + 1) * 132 + tt] = hq[q][1]; hT[(j4 + 2) * 132 + tt] = hq[q][2]; hT[(j4 + 3) * 132 + tt] = hq[q][3]; }
#pragma unroll
          for (int q = 0; q < 2; ++q) { const int idx = q * NTHR + tid, j = idx >> 4, c4 = (idx & 15) * 4; *(LAS f32x4*)(wT + j * 64 + c4) = wq[q]; } }
        __syncthreads();
        const int tg = (tid & 31) * 4, cg4 = (tid >> 5) * 4;
        f32x4 acc[4] = {{0.f, 0.f, 0.f, 0.f}, {0.f, 0.f, 0.f, 0.f}, {0.f, 0.f, 0.f, 0.f}, {0.f, 0.f, 0.f, 0.f}};
#pragma unroll 8
        for (int j = 0; j < FHID; ++j) { const f32x4 h = *(const LAS f32x4*)(hT + j * 132 + tg), w = *(const LAS f32x4*)(wT + j * 64 + cg4);
            acc[0] += h * w[0]; acc[1] += h * w[1]; acc[2] += h * w[2]; acc[3] += h * w[3]; }
        __syncthreads();
#pragma unroll
        for (int ci = 0; ci < 4; ++ci) { const int c = (col0 + cg4 + ci) & (HYW - 1);
            const float dl = fabsf(-15.350567286626973f + (float)c * ((-3.0701134573253946f + 15.350567286626973f) / 1023.0f));
            f32x4 o;
#pragma unroll
            for (int ti = 0; ti < 4; ++ti) o[ti] = acc[ci][ti] * expf(-((float)(t0 + tg + ti) / (float)(SEQL - 1)) * dl);
            *(LAS f32x4*)(hT + (cg4 + ci) * 132 + tg) = o; }
        __syncthreads();
        { const int col = tid >> 3, ch = (tid & 7) * 16, c = (col0 + col) & (HYW - 1); const bool bwd = col0 >= HYW;
          f32x4 v[4];
#pragma unroll
          for (int q = 0; q < 4; ++q) v[q] = *(const LAS f32x4*)(hT + col * 132 + ch + 4 * q);
          float* dst = KT + (size_t)c * FFTN;
          if (!bwd) {
#pragma unroll
              for (int q = 0; q < 4; ++q) *(f32x4*)(dst + t0 + ch + 4 * q) = v[q];
          } else {
              float* d2 = dst + (2 * SEQL - 16) - (t0 + ch);
#pragma unroll
              for (int q = 0; q < 4; ++q) *(f32x4*)(d2 + 4 * q) = (f32x4){v[3 - q][3], v[3 - q][2], v[3 - q][1], v[3 - q][0]};
          } }
    }
}

__device__ __forceinline__ void fft_conv_phase(int layer, unsigned char* lds) {
    const Params p = get_params(); const int bid = BID(), nblk = NBLK();
    LAS f32x2* X = (LAS f32x2*)lds; LAS float* RED = (LAS float*)(lds + FFT_LDS);
    const int tid0 = TID(), wid = tid0 >> 6, lane = tid0 & 63;
    const float* skip = p.in[12] + layer * HYW; const float* KT = p.out;
    const float* Z = (const float*)(p.ws + WS_Z); const bf16_t* X0T = (const bf16_t*)(p.ws + WS_X0T);
    LAS f32x2* T = (LAS f32x2*)(lds + FFT_LDS + 1024);
    fft_build_twiddles(T, tid0);
    for (int c = bid; c < HYW; c += nblk) {
        __syncthreads();
        const int tid = lv(tid0);
        const float* kt = KT + (size_t)c * FFTN;
        float asum = 0.f;
        { float kv[32];
#pragma unroll
          for (int q = 0; q < 32; ++q) kv[q] = kt[q * NTHR + tid];
          PIN16F(kv, 0); PIN16F(kv, 16);
#pragma unroll
          for (int q = 0; q < 32; ++q) { asum += fabsf(kv[q]); X[fpad(q * NTHR + tid)] = (f32x2){kv[q], 0.f}; } }
#pragma unroll
        for (int o = 32; o > 0; o >>= 1) asum += __shfl_xor(asum, o);
        if (lane == 0) RED[wid] = asum;
        __syncthreads();
        float total = 0.f;
#pragma unroll
        for (int i = 0; i < 8; ++i) total += RED[i];
        fft_fwd<false>(X, tid, T);
        const float scale = 1.0f / ((float)FFTN * total);
        f32x2 kreg[32];
#pragma unroll
        for (int q = 0; q < 32; ++q) kreg[q] = X[fpad(q * NTHR + tid)] * scale;
        __syncthreads();
        const float* z0 = Z + (size_t)c * 2 * SEQL; const float* z1 = z0 + SEQL;
        { float za[16], zb[16];
#pragma unroll
          for (int q = 0; q < 16; ++q) { za[q] = z0[q * NTHR + tid]; zb[q] = z1[q * NTHR + tid]; }
          PIN16F(za, 0); PIN16F(zb, 0);
#pragma unroll
          for (int q = 0; q < 16; ++q) X[fpad(q * NTHR + tid)] = (f32x2){za[q], zb[q]}; }
        __syncthreads();
        fft_fwd<true>(X, tid, T);
#pragma unroll
        for (int q = 0; q < 32; ++q) { const int i = fpad(q * NTHR + tid); X[i] = cmul(X[i], kreg[q]); }
        __syncthreads();
        fft_inv_half(X, tid, T);
        const float sk = skip[c];
        const bf16_t* x00 = X0T + (size_t)c * 2 * SEQL; const bf16_t* x01 = x00 + SEQL;
        bf16_t* yt0 = (bf16_t*)(p.ws + WS_YT) + (size_t)c * 2 * SEQL; bf16_t* yt1 = yt0 + SEQL;
#pragma unroll
        for (int hq = 0; hq < 2; ++hq) {
            float za[8], zb[8]; unsigned xa[8], xb[8];
#pragma unroll
            for (int q = 0; q < 8; ++q) { const int t = (hq * 8 + q) * NTHR + tid; za[q] = z0[t]; zb[q] = z1[t]; xa[q] = x00[t]; xb[q] = x01[t]; }
            asm volatile("" : "+v"(za[0]), "+v"(za[1]), "+v"(za[2]), "+v"(za[3]), "+v"(za[4]), "+v"(za[5]), "+v"(za[6]), "+v"(za[7]), "+v"(zb[0]), "+v"(zb[1]), "+v"(zb[2]), "+v"(zb[3]), "+v"(zb[4]), "+v"(zb[5]), "+v"(zb[6]), "+v"(zb[7]));
            asm volatile("" : "+v"(xa[0]), "+v"(xa[1]), "+v"(xa[2]), "+v"(xa[3]), "+v"(xa[4]), "+v"(xa[5]), "+v"(xa[6]), "+v"(xa[7]), "+v"(xb[0]), "+v"(xb[1]), "+v"(xb[2]), "+v"(xb[3]), "+v"(xb[4]), "+v"(xb[5]), "+v"(xb[6]), "+v"(xb[7]));
#pragma unroll
            for (int q = 0; q < 8; ++q) { const int t = (hq * 8 + q) * NTHR + tid;
                const f32x2 y = X[fpad(t)];
                const float ya = __uint_as_float(xa[q] << 16) * (y.x + sk * za[q]), yb = __uint_as_float(xb[q] << 16) * (y.y + sk * zb[q]);
                yt0[t] = (bf16_t)(pk_bf16(ya, ya) & 0xffffu);
                yt1[t] = (bf16_t)(pk_bf16(yb, yb) & 0xffffu); }
        }
    }
}

__device__ __forceinline__ void ytrans_phase(unsigned char* lds) {
    const Params p = get_params(); const int bid = BID(), nblk = NBLK(); const int tid = TID();
    LAS float* T = (LAS float*)lds; constexpr int TS = 64 * 65, NT = 16 * 256;
    const bf16_t* YT = (const bf16_t*)(p.ws + WS_YT); bf16_t* YHY = (bf16_t*)(p.ws + WS_YHY);
    for (int id0 = bid; id0 < NT; id0 += 4 * nblk) {
        u32x4 w[4];
#pragma unroll
        for (int q = 0; q < 4; ++q) { const int id = id0 + q * nblk; if (id < NT) { const int t0 = (id >> 4) * 64, c0 = (id & 15) * 64, cc = tid >> 3, t8 = (tid & 7) * 8;
            w[q] = *(const u32x4*)(YT + ((size_t)(c0 + cc) * 2 + (t0 >> 13)) * SEQL + (t0 & (SEQL - 1)) + t8); } }
#pragma unroll
        for (int q = 0; q < 4; ++q) { const int id = id0 + q * nblk; if (id < NT) { const int cc = tid >> 3, t8 = (tid & 7) * 8; LAS float* d = T + q * TS + t8 * 65 + cc;
            d[0] = bf_lo(w[q].x); d[65] = bf_hi(w[q].x); d[130] = bf_lo(w[q].y); d[195] = bf_hi(w[q].y); d[260] = bf_lo(w[q].z); d[325] = bf_hi(w[q].z); d[390] = bf_lo(w[q].w); d[455] = bf_hi(w[q].w); } }
        __syncthreads();
#pragma unroll
        for (int q = 0; q < 4; ++q) { const int id = id0 + q * nblk; if (id < NT) { const int t0 = (id >> 4) * 64, c0 = (id & 15) * 64, tt = tid >> 3, c8 = (tid & 7) * 8; const LAS float* sp = T + q * TS + tt * 65 + c8;
            u32x4 o; o.x = pk_bf16(sp[0], sp[1]); o.y = pk_bf16(sp[2], sp[3]); o.z = pk_bf16(sp[4], sp[5]); o.w = pk_bf16(sp[6], sp[7]);
            *(u32x4*)(YHY + (size_t)(t0 + tt) * HYW + c0 + c8) = o; } }
        __syncthreads();
    }
}

__device__ __forceinline__ void attention_phase(unsigned char* lds) {
    const Params p = get_params(); const int bid = BID(), nblk = NBLK();
    const att::bf16* QKV = (const att::bf16*)(p.ws + WS_QKV); att::bf16* YAT = (att::bf16*)(p.ws + WS_YAT);
    for (int item = bid; item < NB * NH * (SEQL / 256); item += nblk) {
        const int b = item >> 8, h = (item >> 5) & 7, qb = item & 31, kvh = h >> 2;
        const att::bf16* Q = QKV + ((size_t)b * SEQL + qb * 256) * 1536 + h * HD;
        const att::bf16* K = QKV + ((size_t)b * SEQL) * 1536 + QW + kvh * HD;
        const att::bf16* V = K + KVW;
        att::bf16* O = YAT + ((size_t)b * SEQL + qb * 256) * QW + h * HD;
        __syncthreads();
        att::attn_dense_body<att::bf16>(Q, K, V, O, SEQL, (char*)lds);
    }
    __syncthreads();
}

#define XB_TMO      128
#define XB_XCNT(j)  (256  + 64 * (j))
#define XB_XSUB(j)  (1280 + 64 * (j))
#define XB_XGEN(j)  (2304 + 64 * (j))
#define XB_TOP      3328
#define XB_TOPGEN   3392
#define XCD_BAR_WORDS 3456
#define XB_SPIN_CAP (1u << 18)

__device__ __forceinline__ unsigned xb_ld(unsigned* p)              { return __hip_atomic_load(p, __ATOMIC_RELAXED, __HIP_MEMORY_SCOPE_AGENT); }
__device__ __forceinline__ unsigned xb_add(unsigned* p, unsigned v) { return __hip_atomic_fetch_add(p, v, __ATOMIC_RELAXED, __HIP_MEMORY_SCOPE_AGENT); }
__device__ __forceinline__ unsigned xb_xcc_id() { return (unsigned)__builtin_amdgcn_s_getreg((3 << 11) | 20) & 0xFu; }
#define XB_SPIN(cond, bar) do { unsigned _sp = 0; while (cond) { __builtin_amdgcn_s_sleep(1); \
    if ((++_sp & 255u) == 0u) { if (xb_ld(&(bar)[XB_TMO])) break; if (_sp > XB_SPIN_CAP) { atomicAdd(&(bar)[XB_TMO], 1u); break; } } } } while (0)

struct XcdBarrier {
    unsigned* bar; unsigned x;
    volatile LAS unsigned* st;
};

__device__ __forceinline__ XcdBarrier xcd_barrier_post(unsigned* bar, volatile LAS unsigned* st) {
    XcdBarrier b; b.bar = bar; b.x = xb_xcc_id(); b.st = st;
    if (threadIdx.x == 0) (void)xb_add(&bar[XB_XCNT(b.x)], 1u);
    return b;
}
__device__ __forceinline__ void xcd_barrier_complete(unsigned* bar, unsigned x, unsigned& nloc, unsigned& nx) {
    const unsigned G = gridDim.x * gridDim.y * gridDim.z;
    unsigned sum, cnt, mine, sp = 0u;
    for (;;) {
        sum = 0u; cnt = 0u; mine = 0u;
#pragma unroll
        for (unsigned j = 0; j < 16; ++j) { const unsigned c = xb_ld(&bar[XB_XCNT(j)]); sum += c; cnt += (c > 0u) ? 1u : 0u; mine = (j == x) ? c : mine; }
        if (sum == G) break;
        __builtin_amdgcn_s_sleep(1);
        if ((++sp & 255u) == 0u) { if (xb_ld(&bar[XB_TMO])) break; if (sp > XB_SPIN_CAP) { atomicAdd(&bar[XB_TMO], 1u); break; } }
    }
    nloc = mine > 0u ? mine : 1u; nx = cnt > 0u ? cnt : 1u;
}

__device__ __forceinline__ void xcd_barrier(const XcdBarrier& b) {
    asm volatile("s_waitcnt vmcnt(0)" ::: "memory");
    __syncthreads();
    if (threadIdx.x == 0) {
        unsigned* bar = b.bar;
        __builtin_amdgcn_s_waitcnt(0);
        unsigned nloc = b.st[0], nx = b.st[1];
        if (nloc == 0u) { xcd_barrier_complete(bar, b.x, nloc, nx); b.st[0] = nloc; b.st[1] = nx; }
        const unsigned old = xb_add(&bar[XB_XSUB(b.x)], 1u);
        const unsigned gen = old / nloc;
        if (old + 1u == (gen + 1u) * nloc) {
            __builtin_amdgcn_fence(__ATOMIC_RELEASE, "agent");
            asm volatile("s_waitcnt vmcnt(0)" ::: "memory");
            const unsigned og = xb_add(&bar[XB_TOP], 1u);
            const unsigned tg = og / nx;
            if (og + 1u == (tg + 1u) * nx) xb_add(&bar[XB_TOPGEN], 1u);
            else XB_SPIN(xb_ld(&bar[XB_TOPGEN]) == tg, bar);
            __builtin_amdgcn_fence(__ATOMIC_ACQUIRE, "agent");
            xb_add(&bar[XB_XGEN(b.x)], 1u);
            asm volatile("s_waitcnt vmcnt(0)" ::: "memory");
        } else {
            XB_SPIN(xb_ld(&bar[XB_XGEN(b.x)]) == gen, bar);
            __builtin_amdgcn_fence(__ATOMIC_ACQUIRE, "agent");
            asm volatile("s_waitcnt vmcnt(0)" ::: "memory");
        }
    }
    __syncthreads();
}
__device__ __forceinline__ LnFold make_fold(const Params& p, int sid, int gi, int bi, int glayer, bool is_in) {
    LnFold f; f.stats = sid < 0 ? nullptr : (const float*)(p.ws + WS_STATS) + (size_t)sid * NTOK * 2;
    f.g = p.in[gi] + (size_t)glayer * DM; f.b = p.in[bi] + (size_t)glayer * DM;
    f.pu = (const float*)(p.ws + (is_in ? WS_PUIN : WS_PUUP)); f.pv = (const float*)(p.ws + (is_in ? WS_PVIN : WS_PVUP)); return f;
}
constexpr size_t OUT_RB = (size_t)NTOK * DM * 2;
template <int MODE>
__device__ __forceinline__ void gemm_step(unsigned char* lds, int a_sel, size_t a_off, size_t b_off, int N, int K, int o_sel, size_t o_off, int ldc, int g_sel, size_t g_off, int gofs,
                                          int sid, int gi, int bi, int glayer, bool is_in, int sid_out) {
    const Params p = get_params(); unsigned char* ws = p.ws; unsigned char* od = (unsigned char*)p.out;
    EpiX<MODE> E{(bf16_t*)((o_sel ? od : ws) + o_off), ldc, (bf16_t*)(ws + WS_QKV), (bf16_t*)(ws + WS_G), (const bf16_t*)((g_sel ? od : ws) + g_off), gofs,
                 make_fold(p, sid, gi, bi, glayer, is_in), sid_out < 0 ? nullptr : (float*)(ws + WS_STATS) + (size_t)sid_out * NTOK * 2};
    const bf16_t* A = (const bf16_t*)((a_sel ? od : ws) + a_off);
    if constexpr (MODE == 6) run_gemm<MODE>(lds, A, (const bf16_t*)(ws + b_off), N, K, E, (const bf16_t*)(ws + WS_YAT), (const bf16_t*)(ws + WS_WAT));
    else run_gemm<MODE>(lds, A, (const bf16_t*)(ws + b_off), N, K, E);
}
#define GRID_BAR() xcd_barrier(xbar)
__global__ void __launch_bounds__(NTHR) hyena_gqa_mega(Params p_unused) {
    extern __shared__ __attribute__((aligned(16))) unsigned char lds[];
    cg::grid_group grid = cg::this_grid();

    volatile LAS unsigned* xst = (volatile LAS unsigned*)(lds + XST_OFF);
    if (threadIdx.x < 2) xst[threadIdx.x] = 0u;
    { const Params p = get_params();
      if (blockIdx.x == 0) { unsigned* bw = (unsigned*)(p.ws + WS_BAR); for (int i = threadIdx.x; i < XCD_BAR_WORDS; i += NTHR) bw[i] = 0u; }
      float* st = (float*)(p.ws + WS_STATS); for (int i = blockIdx.x * NTHR + threadIdx.x; i < 3 * NTOK * 2; i += gridDim.x * NTHR) st[i] = 0.f; }
    for (int rep = 0; rep < REP_CONV; ++rep) convert_weights_phase(0, lds);
    ln_phase<0>(1, 2, 0);
    hdn_phase(lds);
    grid.sync();
    XcdBarrier xbar;
    { const Params p = get_params(); xbar = xcd_barrier_post((unsigned*)(p.ws + WS_BAR), xst); }

#pragma nounroll
    for (int layer = 0; layer < DEPTH; ++layer) {
        const int sid_in = layer == 0 ? -1 : 1, sid_mid = layer == 0 ? 0 : 2, lprev = layer == 0 ? 0 : layer - 1;
        for (int rep = 0; rep < REP_PROJ; ++rep) gemm_step<0>(lds, 0, WS_HB, WS_WIN, NIN, DM, 0, WS_PH, 3072, 0, WS_G, 0, sid_in, 22, 23, lprev, true, -1);
        ktime_phase<1>(layer, lds);
        GRID_BAR();
        for (int rep = 0; rep < REP_HPRE; ++rep) hyena_pre_phase(layer, lds);
        qk_rope_phase(layer);
        for (int rep = 0; rep < REP_KT; ++rep) ktime_phase<2>(layer, lds);
        GRID_BAR();
        for (int rep = 0; rep < REP_FFT; ++rep) fft_conv_phase(layer, lds);
        for (int rep = 0; rep < REP_ATT; ++rep) attention_phase(lds);
        GRID_BAR();
        ytrans_phase(lds);
        GRID_BAR();
        for (int rep = 0; rep < REP_P4; ++rep) gemm_step<6>(lds, 0, WS_YHY, WS_WHY, DM, HYW, 0, WS_MRG, DM, 0, WS_G, DM, -1, 22, 23, 0, true, -1);
        GRID_BAR();
        for (int rep = 0; rep < REP_WO; ++rep) gemm_step<5>(lds, 0, WS_MRG, WS_WO, DM, DM, 0, WS_RB, DM, 0, WS_HB, 0, sid_in, 22, 23, lprev, true, sid_mid);
        GRID_BAR();
        for (int rep = 0; rep < REP_UP; ++rep) gemm_step<4>(lds, 0, WS_RB, WS_WUP, DFF, DM, 0, WS_FF, DFF, 0, WS_G, 0, sid_mid, 18, 19, layer, false, -1);
        GRID_BAR();
        for (int rep = 0; rep < REP_DOWN; ++rep) gemm_step<5>(lds, 0, WS_FF, WS_WDN, DM, DFF, 0, WS_HB, DM, 0, WS_RB, 0, sid_mid, 18, 19, layer, false, layer + 1 < DEPTH ? 1 : -1);
        GRID_BAR();
        if (layer + 1 < DEPTH) { convert_weights_phase(layer + 1, lds); GRID_BAR(); }
        else ln_phase<2>(22, 23, layer);
    }
}

extern "C" void kernel_launch(void* const* d_in, const int* in_sizes, int n_in, void* d_out, int out_size, void* d_ws, size_t ws_size, hipStream_t stream) {
    static int grid_blocks = 0;
    if (grid_blocks == 0) {
        if (n_in != 24 || out_size != NTOK * DM || ws_size < WS_END) { fprintf(stderr, "kernel_launch: unexpected shapes (n_in %d out %d ws %zu need %zu)\n", n_in, out_size, ws_size, (size_t)WS_END); grid_blocks = -1; return; }
        int dev = 0, cus = 0, per_cu = 0;
        hipGetDevice(&dev); hipDeviceGetAttribute(&cus, hipDeviceAttributeMultiprocessorCount, dev);
        if (hipFuncSetAttribute((const void*)hyena_gqa_mega, hipFuncAttributeMaxDynamicSharedMemorySize, LDS_BYTES) != hipSuccess) { fprintf(stderr, "kernel_launch: hipFuncSetAttribute failed\n"); grid_blocks = -1; return; }
        hipOccupancyMaxActiveBlocksPerMultiprocessor(&per_cu, (const void*)hyena_gqa_mega, NTHR, LDS_BYTES);
        if (per_cu < 1) { fprintf(stderr, "kernel_launch: occupancy query says 0 blocks/CU\n"); per_cu = 1; }
        grid_blocks = cus * per_cu;
    }
    if (grid_blocks < 0) return;
    Params p{};
    for (int i = 0; i < 24; ++i) p.in[i] = (const float*)d_in[i];
    p.out = (float*)d_out; p.ws = (unsigned char*)d_ws;
    void* args[] = {&p};
    hipError_t e = hipLaunchCooperativeKernel((const void*)hyena_gqa_mega, dim3(grid_blocks), dim3(NTHR), args, LDS_BYTES, stream);
    if (e != hipSuccess) fprintf(stderr, "cooperative launch failed: %s (grid %d)\n", hipGetErrorString(e), grid_blocks);
}
```

```cpp
#include <hip/hip_runtime.h>
#include <hip/hip_bf16.h>
#include <hip/hip_cooperative_groups.h>
#include <cstdio>
#include <cstdint>
namespace cg = cooperative_groups;

constexpr int DM = 2048, NB = 2, SEQL = 8192, NTOK = NB * SEQL, DEPTH = 2, GRIDW = 64;
constexpr int HYW = 1024, FEMB = 33, FHID = 64, HD = 128, NH = 8, NKV = 2, QW = 1024, KVW = 256, DFF = 8192, NIN = 8704;
constexpr float ALPHA_F = 1.4142135623730951f;
constexpr float LN_EPS = 1e-5f, RMS_EPS = 1e-6f;
constexpr int NTHR = 512;
#ifndef WGM_WIDE
#define WGM_WIDE 4
#endif
#ifndef WGM_NARROW
#define WGM_NARROW 2
#endif

#ifndef REP_FFT
#define REP_FFT 1
#endif
#ifndef REP_ATT
#define REP_ATT 1
#endif
#ifndef REP_PROJ
#define REP_PROJ 1
#endif
#ifndef REP_CONV
#define REP_CONV 1
#endif
#ifndef REP_HPRE
#define REP_HPRE 1
#endif
#ifndef REP_UP
#define REP_UP 1
#endif
#ifndef REP_SYNC
#define REP_SYNC 1
#endif
#ifndef REP_FOUT
#define REP_FOUT 1
#endif
#ifndef REP_KT
#define REP_KT 1
#endif
#ifndef REP_DOWN
#define REP_DOWN 1
#endif
#ifndef REP_WO
#define REP_WO 1
#endif
#ifndef REP_P4
#define REP_P4 1
#endif
#ifndef REP_LN0
#define REP_LN0 1
#endif
#ifndef REP_HDN
#define REP_HDN 1
#endif


namespace pg8 {
#define PG8_LAS __attribute__((address_space(3)))
typedef unsigned short bf16_t;
typedef short bf16x8 __attribute__((ext_vector_type(8)));
typedef float f32x4 __attribute__((ext_vector_type(4)));
typedef unsigned u32x4 __attribute__((ext_vector_type(4)));
constexpr int BM = 256, BK = 64, HALF = 128, HTB = HALF * BK * 2  , STAGE_BYTES = 8 * HTB, NXCD = 8;

__host__ __device__ __forceinline__ int lds_byte(int r, int c) { const int st = (r >> 4) * 2 + (c >> 5), rr = r & 15, cc = c & 31, ob = rr * 64 + cc * 2; return st * 1024 + (ob ^ (((ob >> 9) & 1) << 5)); }
__host__ __device__ __forceinline__ void stage_rc(int b, int& R, int& C) { const int st = b / 1024, sb = b % 1024, swz = sb ^ (((sb >> 9) & 1) << 5); R = (st >> 1) * 16 + swz / 64; C = (st & 1) * 32 + (swz % 64) / 2; }
__host__ __device__ __forceinline__ int perm32(int rho) { const int n = rho >> 4, i = rho & 15; return 8 * (i >> 2) + 4 * n + (i & 3); }

struct Unit { int pm, pn; };
struct Gemm { const bf16_t* A; const bf16_t* Bt; int M, N, K; const bf16_t* A2; const bf16_t* Bt2; };

struct StaticOrder {
    int nM, nN, nwg, G, c, WGM;
    __host__ __device__ void init(int M, int N, int G_, int c_, int wgm) { nM = M / BM; nN = N / BM; nwg = nM * nN; G = G_; c = c_; WGM = wgm; }
    __host__ __device__ bool next(int i, Unit& u) const {
        const long L = (long)i * G + c; if (L >= nwg) return false;
        int wgid = (int)L; { const int q = nwg / NXCD, r = nwg % NXCD, xcd = wgid % NXCD, off = wgid / NXCD; wgid = (xcd < r ? xcd * (q + 1) : r * (q + 1) + (xcd - r) * q) + off; }
        const int nig = WGM * nN, gid = wgid / nig, fm = gid * WGM, gsz = (nM - fm) < WGM ? (nM - fm) : WGM;
        u.pm = fm + ((wgid % nig) % gsz); u.pn = (wgid % nig) / gsz; return true;
    }
    __device__ __forceinline__ void a_ready(const Unit&) const {}
    __device__ __forceinline__ void done(const Unit&) const {}
};
__device__ __forceinline__ unsigned cvt_pk_bf16(float lo, float hi) { unsigned r; asm volatile("v_cvt_pk_bf16_f32 %0, %1, %2" : "=v"(r) : "v"(lo), "v"(hi)); return r; }
template <class Epi, class Sched, bool DUAL = false>
__device__ __forceinline__ void gemm_phase(PG8_LAS unsigned char* lds, const Gemm g, const Sched& S, const Epi& E) {
    int tid_ = threadIdx.x; asm volatile("" : "+v"(tid_)); const int tid = tid_, wid = __builtin_amdgcn_readfirstlane(tid >> 6), lane = tid & 63, wr = wid >> 2, wc = wid & 3, fr = lane & 15, fq = lane >> 4;
    const int K = g.K, nt = K / BK;
    unsigned voffA[2], voffB[2];
#pragma unroll
    for (int i = 0; i < 2; ++i) { int R, C; stage_rc(tid * 16 + i * 8192, R, C); const int Rb = Epi::PERM ? ((R & ~31) + perm32(R & 31)) : R;
        voffA[i] = (unsigned)(R * K + C) * 2u; voffB[i] = (unsigned)(Rb * K + C) * 2u; }
    const size_t kstep = (size_t)(BK * 2);
    const size_t hstep = (size_t)HALF * K * 2;
    const size_t tstep = 2 * hstep;
    const unsigned ldsw = (unsigned)wid * 1024u;
    const int aoff = lds_byte(wr * 64 + fr, fq * 8), boff = lds_byte(wc * 32 + fr, fq * 8);
#define PG8_SA(b, h) (((b) * 2 + (h)) * HTB)
#define PG8_SB(b, h) ((4 + (b) * 2 + (h)) * HTB)
#define PG8_STAGE(bufoff, gbase, voff) do { _Pragma("unroll") for (int _i = 0; _i < 2; ++_i) \
        __builtin_amdgcn_global_load_lds((const unsigned*)((const char*)(gbase) + (voff)[_i]), (PG8_LAS unsigned*)(lds + (bufoff) + ldsw + _i * 8192), 16, 0, 0); } while (0)
#define PG8_LDA(dst, b, h) do { _Pragma("unroll") for (int m = 0; m < 4; ++m) _Pragma("unroll") for (int k = 0; k < 2; ++k) dst[m][k] = *(const PG8_LAS bf16x8*)(lds + PG8_SA(b, h) + aoff + m * 2048 + k * 1024); } while (0)
#define PG8_LDB(dst, b, h) do { _Pragma("unroll") for (int n = 0; n < 2; ++n) _Pragma("unroll") for (int k = 0; k < 2; ++k) dst[n][k] = *(const PG8_LAS bf16x8*)(lds + PG8_SB(b, h) + boff + n * 2048 + k * 1024); } while (0)
#define PG8_MMA(ai, bj, At, Bt) do { __builtin_amdgcn_s_setprio(1); _Pragma("unroll") for (int m = 0; m < 4; ++m) _Pragma("unroll") for (int n = 0; n < 2; ++n) _Pragma("unroll") for (int k = 0; k < 2; ++k) \
        acc[ai][bj][m][n] = __builtin_amdgcn_mfma_f32_16x16x32_bf16(Bt[n][k], At[m][k], acc[ai][bj][m][n], 0, 0, 0); __builtin_amdgcn_s_setprio(0); } while (0)
#define PG8_WAIT_V(n) asm volatile("s_waitcnt vmcnt(" #n ")" ::: "memory")
#define PG8_WAIT_L(n) asm volatile("s_waitcnt lgkmcnt(" #n ")" ::: "memory")
#define PG8_BAR __builtin_amdgcn_s_barrier()
#define PG8_SCHED __builtin_amdgcn_sched_barrier(0)
    Unit cur, nxt; int ui = 0;
    if (!S.next(0, cur)) return;
    f32x4 acc[2][2][4][2];
#pragma unroll
    for (int a = 0; a < 2; ++a)
#pragma unroll
        for (int b = 0; b < 2; ++b)
#pragma unroll
            for (int m = 0; m < 4; ++m)
#pragma unroll
                for (int n = 0; n < 2; ++n) acc[a][b][m][n] = (f32x4){0.f, 0.f, 0.f, 0.f};
    bf16x8 At[4][2], B0[2][2], B1[2][2];
    const char* cA = (const char*)g.A + (size_t)cur.pm * tstep; const char* cB = (const char*)g.Bt + (size_t)cur.pn * tstep;
    S.a_ready(cur);
    PG8_STAGE(PG8_SB(0, 0), cB, voffB); PG8_STAGE(PG8_SA(0, 0), cA, voffA); PG8_STAGE(PG8_SB(0, 1), cB + hstep, voffB); PG8_STAGE(PG8_SA(0, 1), cA + hstep, voffA);
    if (wr == 1) PG8_BAR;
    PG8_WAIT_V(4); PG8_BAR;
    PG8_STAGE(PG8_SB(1, 0), cB + kstep, voffB); PG8_STAGE(PG8_SA(1, 0), cA + kstep, voffA); PG8_STAGE(PG8_SB(1, 1), cB + hstep + kstep, voffB);
    PG8_WAIT_V(6); PG8_BAR;
    const char* cA2 = DUAL ? (const char*)g.A2 + (size_t)cur.pm * tstep : cA; const char* cB2 = DUAL ? (const char*)g.Bt2 + (size_t)cur.pn * tstep : cB;
    const int ntt = DUAL ? 2 * nt : nt;
    for (;;) {
        const bool has_next = S.next(ui + 1, nxt);
        const char* nA = has_next ? (const char*)g.A + (size_t)nxt.pm * tstep : cA; const char* nB = has_next ? (const char*)g.Bt + (size_t)nxt.pn * tstep : cB;
        for (int t = 0; t < ntt; t += 2) {
            const bool last = (t == ntt - 2);
            const bool s1 = DUAL && (t + 1 >= nt), s2 = DUAL && (t + 2 >= nt);
            const char* a1 = (s1 ? cA2 + (size_t)(t + 1 - nt) * kstep : cA + (size_t)(t + 1) * kstep);
            const char* a2 = last ? nA : (s2 ? cA2 + (size_t)(t + 2 - nt) * kstep : cA + (size_t)(t + 2) * kstep);
            const char* b2 = last ? nB : (s2 ? cB2 + (size_t)(t + 2 - nt) * kstep : cB + (size_t)(t + 2) * kstep);
            const char* a3 = a2 + kstep; const char* b3 = b2 + kstep;
            if (last && has_next) S.a_ready(nxt);
            PG8_LDB(B0, 0, 0); PG8_SCHED; PG8_LDA(At, 0, 0); PG8_STAGE(PG8_SA(1, 1), a1 + hstep, voffA);
            PG8_WAIT_L(8); PG8_BAR; PG8_WAIT_L(0); PG8_MMA(0, 0, At, B0); PG8_BAR; PG8_SCHED;
            PG8_LDB(B1, 0, 1); PG8_STAGE(PG8_SB(0, 0), b2, voffB);
            PG8_BAR; PG8_WAIT_L(0); PG8_MMA(0, 1, At, B1); PG8_BAR;
            PG8_LDA(At, 0, 1); PG8_STAGE(PG8_SA(0, 0), a2, voffA);
            PG8_BAR; PG8_WAIT_L(0); PG8_MMA(1, 0, At, B0); PG8_BAR; PG8_SCHED;
            PG8_STAGE(PG8_SB(0, 1), b2 + hstep, voffB);
            PG8_WAIT_V(6); PG8_BAR; PG8_MMA(1, 1, At, B1); PG8_BAR;
            PG8_LDB(B0, 1, 0); PG8_SCHED; PG8_LDA(At, 1, 0); PG8_STAGE(PG8_SA(0, 1), a2 + hstep, voffA);
            PG8_WAIT_L(8); PG8_BAR; PG8_WAIT_L(0); PG8_MMA(0, 0, At, B0); PG8_BAR; PG8_SCHED;
            PG8_LDB(B1, 1, 1); PG8_STAGE(PG8_SB(1, 0), b3, voffB);
            PG8_BAR; PG8_WAIT_L(0); PG8_MMA(0, 1, At, B1); PG8_BAR;
            PG8_LDA(At, 1, 1); PG8_STAGE(PG8_SA(1, 0), a3, voffA);
            PG8_BAR; PG8_WAIT_L(0); PG8_MMA(1, 0, At, B0); PG8_BAR; PG8_SCHED;
            PG8_STAGE(PG8_SB(1, 1), b3 + hstep, voffB);
            PG8_WAIT_V(6); PG8_BAR; PG8_MMA(1, 1, At, B1); PG8_BAR;
            if constexpr (DUAL) { if (t == nt - 2) E.mid(acc, cur, wr, wc, fr, fq); }
        }
        if constexpr (!Epi::AFTER_DRAIN) { E(acc, cur, wr, wc, fr, fq); S.done(cur); }
        if (!has_next) break;
#pragma unroll
        for (int a = 0; a < 2; ++a)
#pragma unroll
            for (int b = 0; b < 2; ++b)
#pragma unroll
                for (int m = 0; m < 4; ++m)
#pragma unroll
                    for (int n = 0; n < 2; ++n) acc[a][b][m][n] = (f32x4){0.f, 0.f, 0.f, 0.f};
        cur = nxt; cA = nA; cB = nB; ++ui;
        if (DUAL) { cA2 = (const char*)g.A2 + (size_t)cur.pm * tstep; cB2 = (const char*)g.Bt2 + (size_t)cur.pn * tstep; }
    }
    PG8_WAIT_V(0);
    if (wr == 0) PG8_BAR;
    PG8_BAR;
    if constexpr (Epi::AFTER_DRAIN) { E.fused(acc, cur, wr, wc, fr, fq, lds, wid, lane); S.done(cur); }
#undef PG8_SA
#undef PG8_SB
#undef PG8_STAGE
#undef PG8_LDA

#undef PG8_LDB
#undef PG8_MMA
#undef PG8_WAIT_V
#undef PG8_WAIT_L
#undef PG8_BAR
#undef PG8_SCHED
}
}
namespace att {
using bf16 = __hip_bfloat16;
constexpr int   D = 128, NW = 8, QBLK = 32, KVBLK = 64;
constexpr float SCALE = 0.088388347648318440f;
constexpr float THR = 8.f;
constexpr int SDEPTH = 2;
constexpr int LDQ = 1536, LDK = 1536, LDO = 1024;
constexpr size_t SHM_V = KVBLK * D * 2, SHM_K = KVBLK * D * 2, SHM_ATTN = 2 * SHM_V + 2 * SHM_K + NW * 64 * 4;
using u32x4  = __attribute__((ext_vector_type(4))) unsigned;

using bf16x8 = __attribute__((ext_vector_type(8))) short;
using s16x4  = __attribute__((ext_vector_type(4))) short;
using f32x16 = __attribute__((ext_vector_type(16))) float;
using f32x8  = __attribute__((ext_vector_type(8))) float;
#define KSWZ(row, colB) ((row) * 256 + ((colB) ^ (((row) & 7) << 4)))
#define SBAR() __builtin_amdgcn_sched_barrier(0)
__device__ __forceinline__ int crow(int r, int hi) { return (r & 3) + 8 * (r >> 2) + 4 * hi; }
__device__ __forceinline__ unsigned cvtpk(float lo, float hi) {
  unsigned r; asm volatile("v_cvt_pk_bf16_f32 %0, %1, %2" : "=v"(r) : "v"(lo), "v"(hi)); return r;
}
template <typename TIn> struct Stage;
template <> struct Stage<bf16>  { using T = bf16x8;
  __device__ static __forceinline__ T ld8(const bf16* p) { return *reinterpret_cast<const bf16x8*>(p); }
  __device__ static __forceinline__ bf16x8 tobf(T x) { return x; } };
template <> struct Stage<float> { using T = f32x8;
  __device__ static __forceinline__ T ld8(const float* p) { return *reinterpret_cast<const f32x8*>(p); }
  __device__ static __forceinline__ bf16x8 tobf(T x) {
    u32x4 w = {cvtpk(x[0], x[1]), cvtpk(x[2], x[3]), cvtpk(x[4], x[5]), cvtpk(x[6], x[7])}; return *reinterpret_cast<bf16x8*>(&w); } };

__device__ __forceinline__ void partialSM(f32x16& p0, f32x16& p1, float& m_reg, float& mn, float& alpha) {
  constexpr float C = SCALE * 1.4426950408889634f;
  float pmax = p0[0]; for (int r = 1; r < 16; ++r) pmax = fmaxf(pmax, p0[r]); for (int r = 0; r < 16; ++r) pmax = fmaxf(pmax, p1[r]);
  { auto rr = __builtin_amdgcn_permlane32_swap(__float_as_uint(pmax), __float_as_uint(pmax), false, false);
    pmax = fmaxf(__uint_as_float(rr[0]), __uint_as_float(rr[1])); }
  if (__builtin_expect(__all(pmax - m_reg <= THR / SCALE), 1)) { mn = m_reg; alpha = 1.f; }
  else { mn = fmaxf(m_reg, pmax); alpha = __builtin_amdgcn_exp2f((m_reg - mn) * C); m_reg = mn; }
  float mnC = -mn * C;
  for (int r = 0; r < 16; ++r) p0[r] = fmaf(p0[r], C, mnC); for (int r = 0; r < 16; ++r) p1[r] = fmaf(p1[r], C, mnC);
  for (int r = 0; r < 16; ++r) p0[r] = __builtin_amdgcn_exp2f(p0[r]);
}
__device__ __forceinline__ void finishSM(f32x16& p0, f32x16& p1, float alpha, float& l_reg, bf16x8& pa0, bf16x8& pa1, bf16x8& pa2, bf16x8& pa3) {
  for (int r = 0; r < 16; ++r) p1[r] = __builtin_amdgcn_exp2f(p1[r]);
  float ps = 0; for (int r = 0; r < 16; ++r) ps += p0[r]; for (int r = 0; r < 16; ++r) ps += p1[r];
  { auto rr = __builtin_amdgcn_permlane32_swap(__float_as_uint(ps), __float_as_uint(ps), false, false);
    ps = __uint_as_float(rr[0]) + __uint_as_float(rr[1]); }
  l_reg = l_reg * alpha + ps;
#define PK4(P, BASE, OUT) do { unsigned a0 = cvtpk(P[BASE + 0], P[BASE + 1]), a1 = cvtpk(P[BASE + 2], P[BASE + 3]);   \
    unsigned b0 = cvtpk(P[BASE + 4], P[BASE + 5]), b1 = cvtpk(P[BASE + 6], P[BASE + 7]);                              \
    auto r0 = __builtin_amdgcn_permlane32_swap(a0, b0, false, false); auto r1 = __builtin_amdgcn_permlane32_swap(a1, b1, false, false); \
    u32x4 w = {r0[0], r1[0], r0[1], r1[1]}; OUT = *reinterpret_cast<bf16x8*>(&w); } while (0)
  PK4(p0, 0, pa0); PK4(p0, 8, pa1); PK4(p1, 0, pa2); PK4(p1, 8, pa3);
#undef PK4
}
__device__ __forceinline__ void qkt(f32x16& p0, f32x16& p1, const bf16* Ks, const bf16x8* qr, int r32, int hi) {
  p0 = f32x16{}; p1 = f32x16{};
  for (int d0 = 0; d0 < 8; ++d0) { int cb = (d0 * 16 + hi * 8) * 2;
    bf16x8 b0 = *reinterpret_cast<const bf16x8*>((const char*)Ks + KSWZ(r32, cb));
    bf16x8 b1 = *reinterpret_cast<const bf16x8*>((const char*)Ks + KSWZ(32 + r32, cb));
    p0 = __builtin_amdgcn_mfma_f32_32x32x16_bf16(b0, qr[d0], p0, 0, 0, 0);
    p1 = __builtin_amdgcn_mfma_f32_32x32x16_bf16(b1, qr[d0], p1, 0, 0, 0); }
}
__device__ __forceinline__ int v_st(int k, int c) { const int kk = (k & ~0xC) | ((k & 4) << 1) | ((k & 8) >> 1); return ((kk >> 3) * 4 + (c >> 5)) * 512 + ((kk & 7) * 32 + (c & 31)) * 2; }
__device__ __forceinline__ int v_rd_base(int lane) { return ((lane & 3) << 3) | (((lane >> 2) & 3) << 6) | (((lane >> 4) & 1) << 5) | (((lane >> 5) & 1) << 8); }
constexpr int v_rd_off(int d0, int ks, int half) { return d0 * 512 + ks * 4096 + half * 2048; }
template <int OFF> __device__ __forceinline__ s16x4 tr_read(int vb) {
  s16x4 r; asm volatile("ds_read_b64_tr_b16 %0, %1 offset:%2" : "=&v"(r) : "v"(vb), "i"(OFF) : "memory"); return r;
}
template <int D0> __device__ __forceinline__ void pv_one(f32x16& od, int vb, bf16x8 pa0, bf16x8 pa1, bf16x8 pa2, bf16x8 pa3) {
  const s16x4 l0 = tr_read<v_rd_off(D0, 0, 0)>(vb), h0 = tr_read<v_rd_off(D0, 0, 1)>(vb), l1 = tr_read<v_rd_off(D0, 1, 0)>(vb), h1 = tr_read<v_rd_off(D0, 1, 1)>(vb);
  const s16x4 l2 = tr_read<v_rd_off(D0, 2, 0)>(vb), h2 = tr_read<v_rd_off(D0, 2, 1)>(vb), l3 = tr_read<v_rd_off(D0, 3, 0)>(vb), h3 = tr_read<v_rd_off(D0, 3, 1)>(vb);
  asm volatile("s_waitcnt lgkmcnt(0)" ::: "memory"); SBAR();
#define PK(L, H) (bf16x8){L[0], L[1], L[2], L[3], H[0], H[1], H[2], H[3]}
  od = __builtin_amdgcn_mfma_f32_32x32x16_bf16(pa0, PK(l0, h0), od, 0, 0, 0);
  od = __builtin_amdgcn_mfma_f32_32x32x16_bf16(pa1, PK(l1, h1), od, 0, 0, 0);
  od = __builtin_amdgcn_mfma_f32_32x32x16_bf16(pa2, PK(l2, h2), od, 0, 0, 0);
  od = __builtin_amdgcn_mfma_f32_32x32x16_bf16(pa3, PK(l3, h3), od, 0, 0, 0);
#undef PK
}
__device__ __forceinline__ void pv_d0(f32x16* o, int vb, bf16x8 pa0, bf16x8 pa1, bf16x8 pa2, bf16x8 pa3) {
  pv_one<0>(o[0], vb, pa0, pa1, pa2, pa3); pv_one<1>(o[1], vb, pa0, pa1, pa2, pa3); pv_one<2>(o[2], vb, pa0, pa1, pa2, pa3); pv_one<3>(o[3], vb, pa0, pa1, pa2, pa3);
}

template <typename TQ>
__device__ __forceinline__ void attn_dense_body(const TQ* __restrict__ Qb, const bf16* __restrict__ Kh, const bf16* __restrict__ Vh,
                                                bf16* __restrict__ Ob, int seq, char* lds) {
  using St = Stage<bf16>; using SQ = Stage<TQ>;
  int tid_ = threadIdx.x; asm volatile("" : "+v"(tid_)); const int tid = tid_, wid = tid >> 6, lane = tid & 63, r32 = lane & 31, hi = lane >> 5;
  bf16* V_lds = (bf16*)lds; bf16* K_lds = (bf16*)(lds + 2 * SHM_V);
  float* ws = (float*)(lds + 2 * SHM_V + 2 * SHM_K) + wid * 64; float* li_l = ws; float* al_l = ws + 32;
  float m_reg = -1e30f, l_reg = 0; f32x16 o[4] = {}; bf16x8 qr[8];
  const TQ* Qw = Qb + (long)(wid * QBLK + r32) * LDQ + hi * 8;
#pragma unroll
  for (int d0 = 0; d0 < 8; ++d0) qr[d0] = SQ::tobf(SQ::ld8(Qw + d0 * 16));
  const int sr = tid >> 4, sc = (tid & 15) * 8, vst0 = v_st(sr, sc), vst1 = v_st(32 + sr, sc);
  const int vb0 = (int)(uintptr_t)V_lds + v_rd_base(lane);
  struct { typename St::T vs0, vs1, ks0, ks1; } sr_[SDEPTH];
#define SLOAD(i, k0) do { sr_[i].vs0 = St::ld8(&Vh[(long)((k0) + sr) * LDK + sc]); sr_[i].vs1 = St::ld8(&Vh[(long)((k0) + 32 + sr) * LDK + sc]); \
    sr_[i].ks0 = St::ld8(&Kh[(long)((k0) + sr) * LDK + sc]); sr_[i].ks1 = St::ld8(&Kh[(long)((k0) + 32 + sr) * LDK + sc]); } while (0)
#define SWRITE(b, i) do { *(bf16x8*)((char*)V_lds + (b) * SHM_V + vst0) = St::tobf(sr_[i].vs0);          \
    *(bf16x8*)((char*)V_lds + (b) * SHM_V + vst1) = St::tobf(sr_[i].vs1); int kc = sc * 2;               \
    *(bf16x8*)((char*)K_lds + (b) * SHM_K + KSWZ(sr, kc)) = St::tobf(sr_[i].ks0);                       \
    *(bf16x8*)((char*)K_lds + (b) * SHM_K + KSWZ(32 + sr, kc)) = St::tobf(sr_[i].ks1); } while (0)
#define SWAIT() do { if constexpr (SDEPTH == 2) asm volatile("s_waitcnt vmcnt(4)" ::: "memory"); else asm volatile("s_waitcnt vmcnt(0)" ::: "memory"); } while (0)
#define RESC(a) do { if (__any((a) < 1.f)) { if (hi == 0) al_l[r32] = (a); asm volatile("s_waitcnt lgkmcnt(0)" ::: "memory"); \
    for (int d = 0; d < 4; ++d) for (int r = 0; r < 16; ++r) o[d][r] *= al_l[crow(r, hi)]; } } while (0)
  f32x16 pA0, pA1, pB0, pB1; float mnA, mnB, alA, alB; bf16x8 pa0, pa1, pa2, pa3; const int NT = seq / KVBLK;
  constexpr int SE = 0, SO = SDEPTH - 1;
  SLOAD(SE, 0); asm volatile("s_waitcnt vmcnt(0)" ::: "memory"); SWRITE(0, SE); __syncthreads();
  qkt(pA0, pA1, K_lds, qr, r32, hi); partialSM(pA0, pA1, m_reg, mnA, alA);
  SLOAD(SO, KVBLK); if constexpr (SDEPTH == 2) { if (2 < NT) SLOAD(SE, 2 * KVBLK); }
  SWAIT(); SWRITE(1, SO); __syncthreads();
  for (int j = 1; j + 1 < NT; j += 2) {
    SBAR(); qkt(pB0, pB1, (bf16*)((char*)K_lds + SHM_K), qr, r32, hi);
    finishSM(pA0, pA1, alA, l_reg, pa0, pa1, pa2, pa3); SBAR();
    SLOAD(SO, (j + SDEPTH) * KVBLK); SBAR();
    pv_d0(o, vb0, pa0, pa1, pa2, pa3); partialSM(pB0, pB1, m_reg, mnB, alB);
    __syncthreads(); SWAIT(); SWRITE(0, SE);
    RESC(alB); __syncthreads();
    SBAR(); qkt(pA0, pA1, K_lds, qr, r32, hi);
    finishSM(pB0, pB1, alB, l_reg, pa0, pa1, pa2, pa3); SBAR();
    if (SDEPTH == 1 || j + 3 < NT) SLOAD(SE, (j + 1 + SDEPTH) * KVBLK); SBAR();
    pv_d0(o, vb0 + (int)SHM_V, pa0, pa1, pa2, pa3); partialSM(pA0, pA1, m_reg, mnA, alA);
    __syncthreads(); SWAIT(); SWRITE(1, SO);
    RESC(alA); __syncthreads();
  }
  SBAR(); qkt(pB0, pB1, (bf16*)((char*)K_lds + SHM_K), qr, r32, hi);
  finishSM(pA0, pA1, alA, l_reg, pa0, pa1, pa2, pa3); SBAR();
  pv_d0(o, vb0, pa0, pa1, pa2, pa3); partialSM(pB0, pB1, m_reg, mnB, alB);
  __syncthreads(); RESC(alB);
  finishSM(pB0, pB1, alB, l_reg, pa0, pa1, pa2, pa3); SBAR();
  pv_d0(o, vb0 + (int)SHM_V, pa0, pa1, pa2, pa3);
  if (hi == 0) li_l[r32] = l_reg; asm volatile("s_waitcnt lgkmcnt(0)" ::: "memory");
  float rli[16];
#pragma unroll
  for (int r = 0; r < 16; ++r) rli[r] = __builtin_amdgcn_rcpf(li_l[crow(r, hi)]);
  bf16* Ow = Ob + (long)(wid * QBLK) * LDO;
#pragma unroll
  for (int r = 0; r < 16; ++r) { int orow = crow(r, hi);
#pragma unroll
    for (int d0 = 0; d0 < 4; ++d0) Ow[(long)orow * LDO + d0 * 32 + r32] = __float2bfloat16(o[d0][r] * rli[r]); }
#undef SLOAD
#undef SWRITE
#undef SWAIT
#undef RESC
}

#undef KSWZ
}

#define LAS __attribute__((address_space(3)))
typedef unsigned short bf16_t;
typedef float f32x2 __attribute__((ext_vector_type(2)));
typedef float f32x4 __attribute__((ext_vector_type(4)));
typedef unsigned u32x4 __attribute__((ext_vector_type(4)));
typedef unsigned u32x2 __attribute__((ext_vector_type(2)));

struct Params { const float* in[24]; float* out; unsigned char* ws; };
typedef const __attribute__((address_space(4))) Params* ParamsPtr;
#if defined(__HIP_DEVICE_COMPILE__)
__device__ __forceinline__ Params get_params() { ParamsPtr q = (ParamsPtr)__builtin_amdgcn_kernarg_segment_ptr(); asm volatile("" : "+s"(q)); return *q; }
#else
__device__ __forceinline__ Params get_params() { return Params{}; }
#endif
__device__ __forceinline__ int lv(int x) { asm volatile("" : "+v"(x)); return x; }
__device__ __forceinline__ int ls(int x) { asm volatile("" : "+s"(x)); return x; }
#define TID() lv((int)threadIdx.x)
#define BID() ls((int)blockIdx.x)
#define NBLK() ls((int)gridDim.x)

constexpr size_t SZ_WIN = (size_t)NIN * DM * 2, SZ_WHY = (size_t)DM * HYW * 2, SZ_WAT = (size_t)DM * QW * 2, SZ_WO = (size_t)DM * DM * 2, SZ_WUP = (size_t)DFF * DM * 2, SZ_WDN = (size_t)DM * DFF * 2;
constexpr size_t WS_WIN = 0, WS_WHY = WS_WIN + SZ_WIN, WS_WAT = WS_WHY + SZ_WHY, WS_WO = WS_WAT + SZ_WAT, WS_WUP = WS_WO + SZ_WO, WS_WDN = WS_WUP + SZ_WUP;
constexpr size_t WS_HB = WS_WDN + SZ_WDN;

constexpr size_t WS_X = WS_HB + (size_t)NTOK * DM * 2;
constexpr size_t WS_PH = WS_X, WS_QKV = WS_PH + (size_t)NTOK * 3072 * 2, WS_G = WS_QKV + (size_t)NTOK * 1536 * 2;
constexpr size_t WS_FF = WS_X, WS_YHY = WS_PH, WS_YAT = WS_PH + (size_t)NTOK * HYW * 2, WS_YT = WS_YAT + (size_t)NTOK * QW * 2, WS_MRG = WS_YT;
constexpr size_t WS_R = WS_X + (size_t)NTOK * NIN * 2;
constexpr size_t WS_Z = WS_R, WS_X0T = WS_R + (size_t)HYW * NTOK * 4, WS_RB = WS_R;
constexpr size_t WS_HDN = WS_X0T + (size_t)HYW * NTOK * 2;
constexpr size_t WS_ROPE = WS_HDN + (size_t)DEPTH * SEQL * FHID * 4;
constexpr size_t WS_BAR = WS_ROPE + 128 * 32 * 8;
constexpr size_t WS_STATS = WS_BAR + 3456 * 4;
constexpr size_t WS_PUIN = WS_STATS + (size_t)3 * NTOK * 2 * 4;
constexpr size_t WS_PVIN = WS_PUIN + (size_t)NIN * 4, WS_PUUP = WS_PVIN + (size_t)NIN * 4, WS_PVUP = WS_PUUP + (size_t)DFF * 4;
constexpr size_t WS_END = WS_PVUP + (size_t)DFF * 4;

constexpr int FFTN = 16384, FFT_LDS = (FFTN + FFTN / 16) * 8;
constexpr int XST_OFF = FFT_LDS + 1024 + (1024 + 128 + 16) * 8;
constexpr int LDS_BYTES = XST_OFF + 16;

__device__ __forceinline__ float bf_lo(unsigned w) { return __uint_as_float(w << 16); }
__device__ __forceinline__ float bf_hi(unsigned w) { return __uint_as_float(w & 0xffff0000u); }
__device__ __forceinline__ unsigned pk_bf16(float lo, float hi) { return pg8::cvt_pk_bf16(lo, hi); }

struct LnFold { const float* stats; const float* g; const float* b; const float* pu; const float* pv; };
__device__ __forceinline__ void ln_row_stats(const float* stats, size_t r, float& mean, float& rstd) {
    const f32x2 sq = *(const f32x2*)(stats + 2 * r); mean = sq.x * (1.0f / DM); rstd = rsqrtf(fmaxf(sq.y * (1.0f / DM) - mean * mean, 0.f) + LN_EPS);
}
#define PIN16F(A, B) asm volatile("" : "+v"(A[B]), "+v"(A[B + 1]), "+v"(A[B + 2]), "+v"(A[B + 3]), "+v"(A[B + 4]), "+v"(A[B + 5]), "+v"(A[B + 6]), "+v"(A[B + 7]), \
    "+v"(A[B + 8]), "+v"(A[B + 9]), "+v"(A[B + 10]), "+v"(A[B + 11]), "+v"(A[B + 12]), "+v"(A[B + 13]), "+v"(A[B + 14]), "+v"(A[B + 15]))
__device__ __forceinline__ void pin4(u32x4& a, u32x4& b, u32x4& c, u32x4& d) { asm volatile("" : "+v"(a), "+v"(b), "+v"(c), "+v"(d)); }
__device__ __forceinline__ void pin4f(f32x4& a, f32x4& b, f32x4& c, f32x4& d) { asm volatile("" : "+v"(a), "+v"(b), "+v"(c), "+v"(d)); }
__device__ __forceinline__ void pin8(u32x4& a, u32x4& b, u32x4& c, u32x4& d, u32x4& e, u32x4& f, u32x4& g, u32x4& h) { asm volatile("" : "+v"(a), "+v"(b), "+v"(c), "+v"(d), "+v"(e), "+v"(f), "+v"(g), "+v"(h)); }
__device__ __forceinline__ void pin8f(f32x4& a, f32x4& b, f32x4& c, f32x4& d, f32x4& e, f32x4& f, f32x4& g, f32x4& h) { asm volatile("" : "+v"(a), "+v"(b), "+v"(c), "+v"(d), "+v"(e), "+v"(f), "+v"(g), "+v"(h)); }
template <int MODE> struct EpiX {
    static constexpr bool PERM = true, AFTER_DRAIN = false;
    bf16_t* O; int ldc; bf16_t* O2; bf16_t* O3; const bf16_t* G; int gofs; LnFold f; float* stats_out;
    __device__ __forceinline__ void mid(pg8::f32x4 (&acc)[2][2][4][2], const pg8::Unit& u, int wr, int wc, int fr, int fq) const {
        const int row0 = lv(u.pm * 256 + wr * 64 + fr), col0 = u.pn * 256 + wc * 32 + 8 * fq;
#pragma unroll
        for (int ai = 0; ai < 2; ++ai)
#pragma unroll
            for (int mp = 0; mp < 2; ++mp) {
                u32x4 gh[2][2], ga[2][2];
#pragma unroll
                for (int mm = 0; mm < 2; ++mm)
#pragma unroll
                    for (int bj = 0; bj < 2; ++bj) { const size_t r = (size_t)(row0 + ai * 128 + (mp * 2 + mm) * 16);
                        gh[mm][bj] = *(const u32x4*)(G + r * 4096 + col0 + bj * 128); ga[mm][bj] = *(const u32x4*)(G + r * 4096 + DM + col0 + bj * 128); }
                pin8(gh[0][0], gh[0][1], gh[1][0], gh[1][1], ga[0][0], ga[0][1], ga[1][0], ga[1][1]);
#pragma unroll
                for (int mm = 0; mm < 2; ++mm)
#pragma unroll
                    for (int bj = 0; bj < 2; ++bj) { const int m = mp * 2 + mm; const u32x4 h = gh[mm][bj], a = ga[mm][bj];
                        acc[ai][bj][m][0][0] *= bf_lo(h.x) * __builtin_amdgcn_rcpf(bf_lo(a.x)); acc[ai][bj][m][0][1] *= bf_hi(h.x) * __builtin_amdgcn_rcpf(bf_hi(a.x));
                        acc[ai][bj][m][0][2] *= bf_lo(h.y) * __builtin_amdgcn_rcpf(bf_lo(a.y)); acc[ai][bj][m][0][3] *= bf_hi(h.y) * __builtin_amdgcn_rcpf(bf_hi(a.y));
                        acc[ai][bj][m][1][0] *= bf_lo(h.z) * __builtin_amdgcn_rcpf(bf_lo(a.z)); acc[ai][bj][m][1][1] *= bf_hi(h.z) * __builtin_amdgcn_rcpf(bf_hi(a.z));
                        acc[ai][bj][m][1][2] *= bf_lo(h.w) * __builtin_amdgcn_rcpf(bf_lo(a.w)); acc[ai][bj][m][1][3] *= bf_hi(h.w) * __builtin_amdgcn_rcpf(bf_hi(a.w)); }
            }
    }
    __device__ __forceinline__ void operator()(const pg8::f32x4 (&acc)[2][2][4][2], const pg8::Unit& u, int wr, int wc, int fr, int fq) const {
        const int row0 = lv(u.pm * 256 + wr * 64 + fr); int colt = u.pn * 256; bf16_t* base = O; int ld = ldc; bool sig = false;
        const int colg = u.pn * 256 + wc * 32 + 8 * fq;
        if (MODE == 0) { if (u.pn >= 18) { base = O3; ld = 4096; colt -= 4608; sig = true; } else if (u.pn >= 12) { base = O2; ld = 1536; colt -= 3072; } }
        const int col0 = colt + wc * 32 + 8 * fq;
        constexpr bool FOLD_A = (MODE == 0 || MODE == 4), RES = (MODE == 5), GATE = (MODE == 1 || MODE == 2 || MODE == 6);
        const bool fold = (FOLD_A || RES) && f.stats != nullptr;
        float cu[2][8], cv[2][8]; f32x2 st[2][4];
        if (FOLD_A || RES) {
#pragma unroll
            for (int bj = 0; bj < 2; ++bj)
#pragma unroll
                for (int e = 0; e < 8; ++e) { cu[bj][e] = RES ? 1.f : 0.f; cv[bj][e] = 0.f; }
            if (FOLD_A) {
#pragma unroll
                for (int ai = 0; ai < 2; ++ai)
#pragma unroll
                    for (int m = 0; m < 4; ++m) st[ai][m] = (f32x2){0.f, 0.f}; }
            if (fold) {
                const float* pa = FOLD_A ? f.pu : f.g; const float* pb = FOLD_A ? f.pv : f.b;
                f32x4 t[2][4];
#pragma unroll
                for (int bj = 0; bj < 2; ++bj) { const int c = colg + bj * 128; t[bj][0] = *(const f32x4*)(pa + c); t[bj][1] = *(const f32x4*)(pa + c + 4); t[bj][2] = *(const f32x4*)(pb + c); t[bj][3] = *(const f32x4*)(pb + c + 4); }
                if (FOLD_A) {
#pragma unroll
                    for (int ai = 0; ai < 2; ++ai)
#pragma unroll
                        for (int m = 0; m < 4; ++m) st[ai][m] = *(const f32x2*)(f.stats + 2 * (size_t)(row0 + ai * 128 + m * 16)); }
                if (FOLD_A) asm volatile("" : "+v"(t[0][0]), "+v"(t[0][1]), "+v"(t[0][2]), "+v"(t[0][3]), "+v"(t[1][0]), "+v"(t[1][1]), "+v"(t[1][2]), "+v"(t[1][3]),
                                  "+v"(st[0][0]), "+v"(st[0][1]), "+v"(st[0][2]), "+v"(st[0][3]), "+v"(st[1][0]), "+v"(st[1][1]), "+v"(st[1][2]), "+v"(st[1][3]));
                else pin8f(t[0][0], t[0][1], t[0][2], t[0][3], t[1][0], t[1][1], t[1][2], t[1][3]);
#pragma unroll
                for (int bj = 0; bj < 2; ++bj)
#pragma unroll
                    for (int e = 0; e < 4; ++e) { cu[bj][e] = t[bj][0][e]; cu[bj][4 + e] = t[bj][1][e]; cv[bj][e] = t[bj][2][e]; cv[bj][4 + e] = t[bj][3][e]; }
            }
        }
#pragma unroll
        for (int ai = 0; ai < 2; ++ai) {
            u32x4 xw[4][2];
            if (RES || GATE) {
#pragma unroll
                for (int m = 0; m < 4; ++m)
#pragma unroll
                    for (int bj = 0; bj < 2; ++bj) { const size_t r = (size_t)(row0 + ai * 128 + m * 16);
                        xw[m][bj] = RES ? *(const u32x4*)(G + r * DM + col0 + bj * 128) : *(const u32x4*)(G + r * 4096 + gofs + col0 + bj * 128); }
            }
            f32x2 sr[4] = {{0.f, 0.f}, {0.f, 0.f}, {0.f, 0.f}, {0.f, 0.f}};
            if (RES) { if (fold) {
#pragma unroll
                for (int m = 0; m < 4; ++m) sr[m] = *(const f32x2*)(f.stats + 2 * (size_t)(row0 + ai * 128 + m * 16));
                asm volatile("" : "+v"(sr[0]), "+v"(sr[1]), "+v"(sr[2]), "+v"(sr[3])); } }
            if (RES || GATE) pin8(xw[0][0], xw[0][1], xw[1][0], xw[1][1], xw[2][0], xw[2][1], xw[3][0], xw[3][1]);
#pragma unroll
            for (int m = 0; m < 4; ++m) {
                const size_t r = (size_t)(row0 + ai * 128 + m * 16);
                bf16_t* rowp = base + r * ld + col0;
                float mean = 0.f, rstd = 1.f;
                if ((FOLD_A || RES) && fold) { const f32x2 sq = RES ? sr[m] : st[ai][m]; mean = sq.x * (1.0f / DM); rstd = rsqrtf(fmaxf(sq.y * (1.0f / DM) - mean * mean, 0.f) + LN_EPS); }
                float ssum = 0.f, ssq = 0.f;
#pragma unroll
                for (int bj = 0; bj < 2; ++bj) {
                    float v[8] = {acc[ai][bj][m][0][0], acc[ai][bj][m][0][1], acc[ai][bj][m][0][2], acc[ai][bj][m][0][3], acc[ai][bj][m][1][0], acc[ai][bj][m][1][1], acc[ai][bj][m][1][2], acc[ai][bj][m][1][3]};
                    if (FOLD_A) { if (fold) {
#pragma unroll
                        for (int e = 0; e < 8; ++e) v[e] = rstd * (v[e] - mean * cu[bj][e]) + cv[bj][e]; } }
                    if (MODE == 0) { if (sig) {
#pragma unroll
                        for (int e = 0; e < 8; ++e) v[e] = __builtin_amdgcn_rcpf(1.0f + __expf(-v[e])); } }
                    if (GATE) { const u32x4 gw = xw[m][bj];
                        v[0] *= bf_lo(gw.x); v[1] *= bf_hi(gw.x); v[2] *= bf_lo(gw.y); v[3] *= bf_hi(gw.y); v[4] *= bf_lo(gw.z); v[5] *= bf_hi(gw.z); v[6] *= bf_lo(gw.w); v[7] *= bf_hi(gw.w); }
                    if (MODE == 2) {
                        const u32x4 ow = *(const u32x4*)(rowp + bj * 128);
                        v[0] += bf_lo(ow.x); v[1] += bf_hi(ow.x); v[2] += bf_lo(ow.y); v[3] += bf_hi(ow.y); v[4] += bf_lo(ow.z); v[5] += bf_hi(ow.z); v[6] += bf_lo(ow.w); v[7] += bf_hi(ow.w); }
                    if (RES) { const u32x4 hw = xw[m][bj];
                        const float h[8] = {bf_lo(hw.x), bf_hi(hw.x), bf_lo(hw.y), bf_hi(hw.y), bf_lo(hw.z), bf_hi(hw.z), bf_lo(hw.w), bf_hi(hw.w)};
#pragma unroll
                        for (int e = 0; e < 8; ++e) { const float hh = fold ? ((h[e] - mean) * rstd * cu[bj][e] + cv[bj][e]) : h[e]; v[e] += ALPHA_F * hh; ssum += v[e]; ssq += v[e] * v[e]; } }
                    if (MODE == 4) {
#pragma unroll
                        for (int e = 0; e < 8; ++e) { const float a = fmaxf(v[e], 0.f); v[e] = a * a; } }
                    u32x4 w; w.x = pk_bf16(v[0], v[1]); w.y = pk_bf16(v[2], v[3]); w.z = pk_bf16(v[4], v[5]); w.w = pk_bf16(v[6], v[7]);
                    *(u32x4*)(rowp + bj * 128) = w; }
                if (RES) { if (stats_out != nullptr) {
                    ssum += __shfl_xor(ssum, 16); ssum += __shfl_xor(ssum, 32); ssq += __shfl_xor(ssq, 16); ssq += __shfl_xor(ssq, 32);
                    if (fq == 0) { atomicAdd(stats_out + 2 * r, ssum); atomicAdd(stats_out + 2 * r + 1, ssq); } } }
            }
        }
    }
};

template <int MODE>
__device__ __forceinline__ void run_gemm(unsigned char* lds, const bf16_t* A, const bf16_t* Bt, int N, int K, const EpiX<MODE>& E, const bf16_t* A2 = nullptr, const bf16_t* Bt2 = nullptr) {
    pg8::Gemm g{A, Bt, NTOK, N, K, A2, Bt2}; pg8::StaticOrder S; S.init(NTOK, N, NBLK(), BID(), N >= 8192 ? WGM_WIDE : WGM_NARROW);
    pg8::gemm_phase<EpiX<MODE>, pg8::StaticOrder, MODE == 6>((PG8_LAS unsigned char*)lds, g, S, E);
}

struct CvtJob { const float* src; bf16_t* dst; int K, N, tk, tn; };
__device__ __forceinline__ CvtJob cvt_plain_job(const Params& p, int layer, int id) {
    CvtJob j; int loc; unsigned char* ws = p.ws;
    if (id < 512)        { loc = id;         j.K = HYW; j.N = DM;  j.src = p.in[15] + (size_t)layer * HYW * DM;  j.dst = (bf16_t*)(ws + WS_WHY); }
    else if (id < 1024)  { loc = id - 512;   j.K = QW;  j.N = DM;  j.src = p.in[16] + (size_t)layer * QW * DM;   j.dst = (bf16_t*)(ws + WS_WAT); }
    else if (id < 2048)  { loc = id - 1024;  j.K = DM;  j.N = DM;  j.src = p.in[17] + (size_t)layer * DM * DM;   j.dst = (bf16_t*)(ws + WS_WO); }
    else                 { loc = id - 2048;  j.K = DFF; j.N = DM;  j.src = p.in[21] + (size_t)layer * DFF * DM;  j.dst = (bf16_t*)(ws + WS_WDN); }
    const int ntn = j.N >> 6; j.tk = loc / ntn; j.tn = loc - j.tk * ntn; return j;
}
__device__ __forceinline__ void convert_weights_phase(int layer, unsigned char* lds) {
    const Params p = get_params(); const int bid = BID(), nblk = NBLK();
    LAS float* tile = (LAS float*)lds; const int tid = TID();
    constexpr int TS = 64 * 65, NS_IN = 136, NS = 264, NPLAIN = 768;
    const bool bal = (nblk == 256);
    const int nstrip_mine = bal ? (bid < 8 ? 2 : 1) : (NS - bid + nblk - 1) / nblk;
    const int plain0 = bal ? bid - 8 : bid, pstep = bal ? 248 : nblk;
    const int nplain_mine = (bal && bid < 8) ? 0 : (plain0 < NPLAIN ? (NPLAIN - plain0 + pstep - 1) / pstep : 0);
    const int nsteps = nstrip_mine * 4 + nplain_mine;
    float pu = 0.f, pv = 0.f;
    for (int st = 0; st < nsteps; ++st) {
        const bool strip = st < nstrip_mine * 4;
        const int sidx = bal ? bid + 256 * (st >> 2) : bid + nblk * (st >> 2), sq = st & 3;
        const bool is_in = sidx < NS_IN; const int stn = is_in ? sidx : sidx - NS_IN;
        CvtJob sj; sj.K = DM; sj.N = is_in ? NIN : DFF; sj.tn = stn; sj.tk = sq * 8;
        sj.src = is_in ? p.in[3] + (size_t)layer * DM * NIN : p.in[20] + (size_t)layer * DM * DFF; sj.dst = (bf16_t*)(p.ws + (is_in ? WS_WIN : WS_WUP));
        const float* fg = is_in ? (layer > 0 ? p.in[22] + (size_t)(layer - 1) * DM : nullptr) : p.in[18] + (size_t)layer * DM;
        const float* fb = is_in ? (layer > 0 ? p.in[23] + (size_t)(layer - 1) * DM : nullptr) : p.in[19] + (size_t)layer * DM;
        const int pbase = (plain0 + pstep * (st - nstrip_mine * 4)) * 8;
        f32x4 a[8], b[8];
#pragma unroll
        for (int q = 0; q < 8; ++q) { CvtJob j = sj; if (strip) j.tk = sj.tk + q; else j = cvt_plain_job(p, layer, pbase + q);
            const int kk = tid >> 3, n8 = (tid & 7) * 8; const float* s = j.src + (size_t)(j.tk * 64 + kk) * j.N + j.tn * 64 + n8;
            a[q] = __builtin_nontemporal_load((const f32x4*)s); b[q] = __builtin_nontemporal_load((const f32x4*)(s + 4)); }
        LAS float* gbs = tile + 8 * TS;
        if (strip && sq == 0 && fg != nullptr) { const f32x4 gq = *(const f32x4*)(fg + tid * 4), bq = *(const f32x4*)(fb + tid * 4); *(LAS f32x4*)(gbs + tid * 4) = gq; *(LAS f32x4*)(gbs + DM + tid * 4) = bq; }
#pragma unroll
        for (int q = 0; q < 8; ++q) { const int kk = tid >> 3, n8 = (tid & 7) * 8;
            LAS float* d = tile + q * TS + kk * 65 + n8; d[0] = a[q][0]; d[1] = a[q][1]; d[2] = a[q][2]; d[3] = a[q][3]; d[4] = b[q][0]; d[5] = b[q][1]; d[6] = b[q][2]; d[7] = b[q][3]; }
        __syncthreads();
        if (strip && sq == 0) { pu = 0.f; pv = 0.f; }
#pragma unroll
        for (int q = 0; q < 8; ++q) { CvtJob j = sj; if (strip) j.tk = sj.tk + q; else j = cvt_plain_job(p, layer, pbase + q);
            const int n = tid >> 3, k8 = (tid & 7) * 8; float v[8];
#pragma unroll
            for (int e = 0; e < 8; ++e) v[e] = tile[q * TS + (k8 + e) * 65 + n];
            if (strip) { const int k0 = j.tk * 64 + k8;
                if (fg != nullptr) { const f32x4 g0 = *(const LAS f32x4*)(gbs + k0), g1 = *(const LAS f32x4*)(gbs + k0 + 4), b0 = *(const LAS f32x4*)(gbs + DM + k0), b1 = *(const LAS f32x4*)(gbs + DM + k0 + 4);
#pragma unroll
                    for (int e = 0; e < 4; ++e) { pv += b0[e] * v[e] + b1[e] * v[4 + e]; v[e] *= g0[e]; v[4 + e] *= g1[e]; } } }
            u32x4 w; w.x = pk_bf16(v[0], v[1]); w.y = pk_bf16(v[2], v[3]); w.z = pk_bf16(v[4], v[5]); w.w = pk_bf16(v[6], v[7]);
            if (strip) pu += ((bf_lo(w.x) + bf_hi(w.x)) + (bf_lo(w.y) + bf_hi(w.y))) + ((bf_lo(w.z) + bf_hi(w.z)) + (bf_lo(w.w) + bf_hi(w.w)));
            *(u32x4*)(j.dst + (size_t)(j.tn * 64 + n) * j.K + j.tk * 64 + k8) = w; }
        if (strip && sq == 3) {
            float ru = pu, rv = pv;
            ru += __shfl_xor(ru, 1); ru += __shfl_xor(ru, 2); ru += __shfl_xor(ru, 4); rv += __shfl_xor(rv, 1); rv += __shfl_xor(rv, 2); rv += __shfl_xor(rv, 4);
            if ((tid & 7) == 0) { const int n = stn * 64 + (tid >> 3); ((float*)(p.ws + (is_in ? WS_PUIN : WS_PUUP)))[n] = ru; ((float*)(p.ws + (is_in ? WS_PVIN : WS_PVUP)))[n] = rv; } }
        __syncthreads();
    }
}

template <int MODE>
__device__ __forceinline__ void ln_row_load(const Params& p, const bf16_t* rsrc, int row, int lane, float (&v)[32]) {
    if (MODE == 0) {
#pragma unroll
        for (int k = 0; k < 8; ++k) { const f32x4 x = *(const f32x4*)(p.in[0] + (size_t)row * DM + (k * 64 + lane) * 4); v[4 * k] = x[0]; v[4 * k + 1] = x[1]; v[4 * k + 2] = x[2]; v[4 * k + 3] = x[3]; }
    } else {
#pragma unroll
        for (int k = 0; k < 4; ++k) { const u32x4 w = *(const u32x4*)(rsrc + (size_t)row * DM + (k * 64 + lane) * 8);
            v[8 * k] = bf_lo(w.x); v[8 * k + 1] = bf_hi(w.x); v[8 * k + 2] = bf_lo(w.y); v[8 * k + 3] = bf_hi(w.y); v[8 * k + 4] = bf_lo(w.z); v[8 * k + 5] = bf_hi(w.z); v[8 * k + 6] = bf_lo(w.w); v[8 * k + 7] = bf_hi(w.w); }
    }
}
template <int MODE>
__device__ __forceinline__ void ln_load_gb(const float* g, const float* b, int lane, float (&gg)[32], float (&bb)[32]) {
    f32x4 tg[8], tb[8];
#pragma unroll
    for (int k = 0; k < 8; ++k) { const int c = MODE == 0 ? (k * 64 + lane) * 4 : ((k >> 1) * 64 + lane) * 8 + (k & 1) * 4; tg[k] = *(const f32x4*)(g + c); tb[k] = *(const f32x4*)(b + c); }
    pin8f(tg[0], tg[1], tg[2], tg[3], tg[4], tg[5], tg[6], tg[7]); pin8f(tb[0], tb[1], tb[2], tb[3], tb[4], tb[5], tb[6], tb[7]);
#pragma unroll
    for (int k = 0; k < 8; ++k)
#pragma unroll
        for (int e = 0; e < 4; ++e) { gg[4 * k + e] = tg[k][e]; bb[4 * k + e] = tb[k][e]; }
}
template <int MODE>
__device__ __forceinline__ void ln_row_finish(const Params& p, const float (&gg)[32], const float (&bb)[32], bf16_t* hb, int row, int lane, const float (&v)[32]) {
    float sum = 0.f;
#pragma unroll
    for (int e = 0; e < 32; ++e) sum += v[e];
#pragma unroll
    for (int o = 32; o > 0; o >>= 1) sum += __shfl_xor(sum, o);
    const float mean = sum * (1.0f / DM);
    float q = 0.f;
#pragma unroll
    for (int e = 0; e < 32; ++e) { const float d = v[e] - mean; q += d * d; }
#pragma unroll
    for (int o = 32; o > 0; o >>= 1) q += __shfl_xor(q, o);
    const float rstd = rsqrtf(q * (1.0f / DM) + LN_EPS);
    float o[32];
#pragma unroll
    for (int e = 0; e < 32; ++e) o[e] = (v[e] - mean) * rstd * gg[e] + bb[e];
    if (MODE == 0) {
#pragma unroll
        for (int k = 0; k < 8; ++k) { const int c = (k * 64 + lane) * 4; u32x2 w; w.x = pk_bf16(o[4 * k], o[4 * k + 1]); w.y = pk_bf16(o[4 * k + 2], o[4 * k + 3]); *(u32x2*)(hb + (size_t)row * DM + c) = w; }
    } else {
#pragma unroll
        for (int k = 0; k < 4; ++k) { const int c = (k * 64 + lane) * 8;
            if (MODE == 1) { u32x4 w; w.x = pk_bf16(o[8 * k], o[8 * k + 1]); w.y = pk_bf16(o[8 * k + 2], o[8 * k + 3]); w.z = pk_bf16(o[8 * k + 4], o[8 * k + 5]); w.w = pk_bf16(o[8 * k + 6], o[8 * k + 7]); *(u32x4*)(hb + (size_t)row * DM + c) = w; }
            else { *(f32x4*)(p.out + (size_t)row * DM + c) = (f32x4){o[8 * k], o[8 * k + 1], o[8 * k + 2], o[8 * k + 3]}; *(f32x4*)(p.out + (size_t)row * DM + c + 4) = (f32x4){o[8 * k + 4], o[8 * k + 5], o[8 * k + 6], o[8 * k + 7]}; } }
    }
}
template <int MODE>
__device__ __forceinline__ void ln_phase(int gi, int bi, int layer) {
    const Params p = get_params(); const int bid = BID(), nblk = NBLK();
    const float* g = p.in[gi] + layer * DM; const float* b = p.in[bi] + layer * DM; bf16_t* hb = (bf16_t*)(p.ws + WS_HB);
    const bf16_t* rsrc = (const bf16_t*)(p.ws + WS_HB);
    const int tid = TID(), wid = tid >> 6, lane = tid & 63; const int rstride = nblk * 8;
    float gg[32], bb[32]; ln_load_gb<MODE>(g, b, lane, gg, bb);
    for (int row = bid * 8 + wid; row < NTOK; row += 2 * rstride) {
        float v0[32], v1[32]; const int row1 = row + rstride;
        ln_row_load<MODE>(p, rsrc, row, lane, v0);
        if (row1 < NTOK) ln_row_load<MODE>(p, rsrc, row1, lane, v1);
        ln_row_finish<MODE>(p, gg, bb, hb, row, lane, v0);
        if (row1 < NTOK) ln_row_finish<MODE>(p, gg, bb, hb, row1, lane, v1);
    }
}

__device__ __forceinline__ void hdn_phase(unsigned char* lds) {
    const Params p = get_params(); const int bid = BID(), nblk = NBLK();
    LAS float* feats = (LAS float*)lds;
    LAS float* h1 = feats + 64 * 33;
    const int tid = TID(); float* HDN = (float*)(p.ws + WS_HDN);
    { f32x2* TAB = (f32x2*)(p.ws + WS_ROPE);
      for (int i = bid * NTHR + tid; i < 128 * 32; i += nblk * NTHR) { const int pos = i >> 5, ii = i & 31;
          const float inv = exp2f(-(float)ii * (13.287712379549449f / 32.0f)); float sn, cs; sincosf((float)pos * inv, &sn, &cs); TAB[i] = (f32x2){cs, sn}; } }
    for (int it = bid; it < DEPTH * (SEQL / 64); it += nblk) {
        const int layer = it / (SEQL / 64), t0 = (it - layer * (SEQL / 64)) * 64;
        const float* w1 = p.in[6] + layer * FEMB * FHID; const float* b1 = p.in[7] + layer * FHID;
        const float* w2 = p.in[8] + layer * FHID * FHID; const float* b2 = p.in[9] + layer * FHID; const float* fr = p.in[11] + layer * FHID;
        __syncthreads();
#pragma unroll
        for (int q = 0; q < 2; ++q) { const int idx = q * NTHR + tid, tt = idx >> 4, bnd = idx & 15, pos = t0 + tt;
            const float wv = 6.283185307179586f * (float)pos / (float)SEQL; const float fb = 1e-4f + (float)bnd * ((15.0f - 1e-4f) / 15.0f);
            float sn, cs; sincosf(wv * fb, &sn, &cs); feats[tt * 33 + 1 + bnd] = cs; feats[tt * 33 + 17 + bnd] = -sn;
            if (bnd == 0) feats[tt * 33] = (float)pos / (float)(SEQL - 1); }
        __syncthreads();
        const int tt = tid >> 3, j8 = (tid & 7) * 8;
        { f32x4 a0 = *(const f32x4*)(b1 + j8), a1 = *(const f32x4*)(b1 + j8 + 4);
#pragma unroll 3
          for (int i = 0; i < FEMB; ++i) { const float f = feats[tt * 33 + i]; a0 += f * *(const f32x4*)(w1 + i * FHID + j8); a1 += f * *(const f32x4*)(w1 + i * FHID + j8 + 4); }
          const f32x4 f0 = *(const f32x4*)(fr + j8), f1 = *(const f32x4*)(fr + j8 + 4);
#pragma unroll
          for (int e = 0; e < 4; ++e) { h1[tt * 65 + j8 + e] = sinf(f0[e] * a0[e]); h1[tt * 65 + j8 + 4 + e] = sinf(f1[e] * a1[e]); } }
        __syncthreads();
        { f32x4 a0 = *(const f32x4*)(b2 + j8), a1 = *(const f32x4*)(b2 + j8 + 4);
#pragma unroll 4
          for (int i = 0; i < FHID; ++i) { const float f = h1[tt * 65 + i]; a0 += f * *(const f32x4*)(w2 + i * FHID + j8); a1 += f * *(const f32x4*)(w2 + i * FHID + j8 + 4); }
          const f32x4 f0 = *(const f32x4*)(fr + j8), f1 = *(const f32x4*)(fr + j8 + 4);
          f32x4 o0, o1;
#pragma unroll
          for (int e = 0; e < 4; ++e) { o0[e] = sinf(f0[e] * a0[e]); o1[e] = sinf(f1[e] * a1[e]); }
          float* dst = HDN + ((size_t)layer * SEQL + t0 + tt) * FHID + j8; *(f32x4*)dst = o0; *(f32x4*)(dst + 4) = o1; }
    }
}

__device__ __forceinline__ void hyena_pre_phase(int layer, unsigned char* lds) {
    const Params p = get_params(); const int bid = BID(), nblk = NBLK();
    LAS float* zs = (LAS float*)lds; constexpr int TS = 2 * 64 * 65;
    const int tid = TID();
    const bf16_t* PH = (const bf16_t*)(p.ws + WS_PH); float* Z = (float*)(p.ws + WS_Z); bf16_t* X0T = (bf16_t*)(p.ws + WS_X0T);
    const float* cw = p.in[4] + (size_t)layer * 3 * 3072; const float* cb = p.in[5] + (size_t)layer * 3072;
    for (int tile0 = bid; tile0 < 4096; tile0 += 2 * nblk) {
        u32x4 xr[2][3][3];
#pragma unroll
        for (int u = 0; u < 2; ++u) { const int tile = tile0 + u * nblk; if (tile < 4096) {
            const int t0 = (tile >> 4) * 64, c0 = (tile & 15) * 64, tt = tid >> 3, cg8 = (tid & 7) * 8, t = t0 + tt, tl = t & (SEQL - 1);
#pragma unroll
            for (int g = 0; g < 3; ++g) { const bf16_t* pr = PH + (size_t)t * 3072 + g * 1024 + c0 + cg8; const u32x4 z4 = {0u, 0u, 0u, 0u};
                xr[u][g][0] = tl > 0 ? *(const u32x4*)(pr - 3072) : z4; xr[u][g][1] = *(const u32x4*)pr; xr[u][g][2] = tl < SEQL - 1 ? *(const u32x4*)(pr + 3072) : z4; } } }
        __syncthreads();
#pragma unroll
        for (int u = 0; u < 2; ++u) { const int tile = tile0 + u * nblk; if (tile < 4096) {
            const int c0 = (tile & 15) * 64, tt = tid >> 3, cg8 = (tid & 7) * 8;
            float o[3][8];
#pragma unroll
            for (int g = 0; g < 3; ++g) {
                const int ch = g * 1024 + c0 + cg8; const u32x4 xm = xr[u][g][0], xc = xr[u][g][1], xp = xr[u][g][2];
                const f32x4 w0a = *(const f32x4*)(cw + ch), w0b = *(const f32x4*)(cw + ch + 4);
                const f32x4 w1a = *(const f32x4*)(cw + 3072 + ch), w1b = *(const f32x4*)(cw + 3072 + ch + 4);
                const f32x4 w2a = *(const f32x4*)(cw + 6144 + ch), w2b = *(const f32x4*)(cw + 6144 + ch + 4);
                const f32x4 ba = *(const f32x4*)(cb + ch), bb = *(const f32x4*)(cb + ch + 4);
                o[g][0] = bf_lo(xm.x) * w0a[0] + bf_lo(xc.x) * w1a[0] + bf_lo(xp.x) * w2a[0] + ba[0];
                o[g][1] = bf_hi(xm.x) * w0a[1] + bf_hi(xc.x) * w1a[1] + bf_hi(xp.x) * w2a[1] + ba[1];
                o[g][2] = bf_lo(xm.y) * w0a[2] + bf_lo(xc.y) * w1a[2] + bf_lo(xp.y) * w2a[2] + ba[2];
                o[g][3] = bf_hi(xm.y) * w0a[3] + bf_hi(xc.y) * w1a[3] + bf_hi(xp.y) * w2a[3] + ba[3];
                o[g][4] = bf_lo(xm.z) * w0b[0] + bf_lo(xc.z) * w1b[0] + bf_lo(xp.z) * w2b[0] + bb[0];
                o[g][5] = bf_hi(xm.z) * w0b[1] + bf_hi(xc.z) * w1b[1] + bf_hi(xp.z) * w2b[1] + bb[1];
                o[g][6] = bf_lo(xm.w) * w0b[2] + bf_lo(xc.w) * w1b[2] + bf_lo(xp.w) * w2b[2] + bb[2];
                o[g][7] = bf_hi(xm.w) * w0b[3] + bf_hi(xc.w) * w1b[3] + bf_hi(xp.w) * w2b[3] + bb[3];
            }
            LAS float* zt = zs + u * TS; LAS float* xt = zt + 64 * 65;
#pragma unroll
            for (int e = 0; e < 8; ++e) { zt[(cg8 + e) * 65 + tt] = o[2][e] * o[1][e]; xt[(cg8 + e) * 65 + tt] = o[0][e]; } } }
        __syncthreads();
#pragma unroll
        for (int u = 0; u < 2; ++u) { const int tile = tile0 + u * nblk; if (tile < 4096) {
            const int t0 = (tile >> 4) * 64, c0 = (tile & 15) * 64;
            const int c = tid >> 3, tq = (tid & 7) * 8; const int bidx = t0 >> 13, tl0 = t0 & (SEQL - 1);
            const LAS float* zt = zs + u * TS; const LAS float* xt = zt + 64 * 65;
            float zv[8], xv[8];
#pragma unroll
            for (int e = 0; e < 8; ++e) { zv[e] = zt[c * 65 + tq + e]; xv[e] = xt[c * 65 + tq + e]; }
            const size_t off = ((size_t)(c0 + c) * 2 + bidx) * SEQL + tl0 + tq;
            *(f32x4*)(Z + off) = (f32x4){zv[0], zv[1], zv[2], zv[3]}; *(f32x4*)(Z + off + 4) = (f32x4){zv[4], zv[5], zv[6], zv[7]};
            u32x4 w; w.x = pk_bf16(xv[0], xv[1]); w.y = pk_bf16(xv[2], xv[3]); w.z = pk_bf16(xv[4], xv[5]); w.w = pk_bf16(xv[6], xv[7]);
            *(u32x4*)(X0T + off) = w; } }
    }
}

__device__ __forceinline__ void qk_rope_phase(int layer) {
    const Params p = get_params(); const int bid = BID(), nblk = NBLK();
    const int tid = TID(), sub = tid & 15;
    bf16_t* QKV = (bf16_t*)(p.ws + WS_QKV);
    const float* qn = p.in[13] + layer * HD; const float* kn = p.in[14] + layer * HD;
    const int vstride = nblk * 32;
    for (int vi0 = bid * 32 + (tid >> 4); vi0 < NTOK * 10; vi0 += 4 * vstride) {
        u32x4 w[4]; f32x4 tb[4][4]; f32x4 ga[4], gb[4];
#pragma unroll
        for (int u = 0; u < 4; ++u) { const int vi = vi0 + u * vstride; if (vi < NTOK * 10) {
            const int t = vi / 10, hh = vi - t * 10, tl = t & (SEQL - 1);
            w[u] = *(const u32x4*)(QKV + (size_t)t * 1536 + hh * HD + sub * 8);
            const int pos = (sub >> 3) == 0 ? (tl >> 6) : (tl & 63);
            const f32x4* tp = (const f32x4*)(p.ws + WS_ROPE) + (pos * 32 + (sub & 3) * 8) / 2;
#pragma unroll
            for (int e2 = 0; e2 < 4; ++e2) tb[u][e2] = tp[e2];
            const float* gp = (hh < 8 ? qn : kn) + sub * 8; ga[u] = *(const f32x4*)gp; gb[u] = *(const f32x4*)(gp + 4); } }
#pragma unroll
        for (int u = 0; u < 4; ++u) { const int vi = vi0 + u * vstride; if (vi < NTOK * 10) {
            const int t = vi / 10, hh = vi - t * 10;
            float x[8] = {bf_lo(w[u].x), bf_hi(w[u].x), bf_lo(w[u].y), bf_hi(w[u].y), bf_lo(w[u].z), bf_hi(w[u].z), bf_lo(w[u].w), bf_hi(w[u].w)};
            float ss = 0.f;
#pragma unroll
            for (int e = 0; e < 8; ++e) ss += x[e] * x[e];
            ss += __shfl_xor(ss, 1); ss += __shfl_xor(ss, 2); ss += __shfl_xor(ss, 4); ss += __shfl_xor(ss, 8);
            const float rs = rsqrtf(ss * (1.0f / HD) + RMS_EPS);
            x[0] *= rs * ga[u][0]; x[1] *= rs * ga[u][1]; x[2] *= rs * ga[u][2]; x[3] *= rs * ga[u][3]; x[4] *= rs * gb[u][0]; x[5] *= rs * gb[u][1]; x[6] *= rs * gb[u][2]; x[7] *= rs * gb[u][3];
            const bool hi_half = ((sub >> 2) & 1) != 0;
            float y[8];
#pragma unroll
            for (int e2 = 0; e2 < 4; ++e2) {
                const f32x4 cs = tb[u][e2];
                const float o0 = __shfl_xor(x[2 * e2], 4), o1 = __shfl_xor(x[2 * e2 + 1], 4);
                y[2 * e2]     = hi_half ? (x[2 * e2] * cs[0] + o0 * cs[1]) : (x[2 * e2] * cs[0] - o0 * cs[1]);
                y[2 * e2 + 1] = hi_half ? (x[2 * e2 + 1] * cs[2] + o1 * cs[3]) : (x[2 * e2 + 1] * cs[2] - o1 * cs[3]);
            }
            u32x4 o; o.x = pk_bf16(y[0], y[1]); o.y = pk_bf16(y[2], y[3]); o.z = pk_bf16(y[4], y[5]); o.w = pk_bf16(y[6], y[7]);
            *(u32x4*)(QKV + (size_t)t * 1536 + hh * HD + sub * 8) = o; } }
    }
}

__device__ __forceinline__ int fpad(int i) { return i + (i >> 4); }
__device__ __forceinline__ f32x2 cmul(f32x2 a, f32x2 b) { return (f32x2){a.x * b.x - a.y * b.y, a.x * b.y + a.y * b.x}; }
__device__ __forceinline__ constexpr float c16(int k) { return k == 0 ? 1.0f : k == 1 ? 0.9238795325112867f : k == 2 ? 0.7071067811865476f : k == 3 ? 0.3826834323650898f : k == 4 ? 0.0f : k == 5 ? -0.3826834323650898f : k == 6 ? -0.7071067811865476f : -0.9238795325112867f; }
__device__ __forceinline__ constexpr float s16(int k) { return k == 0 ? 0.0f : k == 1 ? 0.3826834323650898f : k == 2 ? 0.7071067811865476f : k == 3 ? 0.9238795325112867f : k == 4 ? 1.0f : k == 5 ? 0.9238795325112867f : k == 6 ? 0.7071067811865476f : 0.3826834323650898f; }

template <int LOGR, int SLOG, bool INV, bool HALF_IN = false, bool HALF_OUT = false>
__device__ __forceinline__ void fft_pass(LAS f32x2* X, int tid_in, const LAS f32x2* TW) {
    constexpr int R = 1 << LOGR, STRIDE = 1 << SLOG, NIT = FFTN / R, PER = (LOGR == 4 ? 1 : 2);
    const int tid = lv(tid_in);
#pragma unroll 1
    for (int w0 = tid; w0 < NIT; w0 += PER * NTHR) {
#pragma unroll
      for (int u = 0; u < PER; ++u) {
        const int w = w0 + u * NTHR;
        const int r = w & (STRIDE - 1), i0 = ((w >> SLOG) << (SLOG + LOGR)) + r;
        f32x2 v[R];
#pragma unroll
        for (int j = 0; j < (HALF_IN ? R / 2 : R); ++j) v[j] = X[fpad(i0 + j * STRIDE)];
        f32x2 wp[LOGR];
        if (SLOG == 0) {
#pragma unroll
            for (int s = 0; s < LOGR; ++s) wp[s] = (f32x2){1.0f, 0.0f};
        } else {
            const f32x2 t0 = TW[r]; wp[0] = INV ? (f32x2){t0.x, -t0.y} : t0;
#pragma unroll
            for (int s = 1; s < LOGR; ++s) wp[s] = cmul(wp[s - 1], wp[s - 1]);
        }
        if (!INV) {
#pragma unroll
            for (int s = 0; s < LOGR; ++s) {
                const int half = R >> (s + 1);
#pragma unroll
                for (int j = 0; j < R; ++j) if ((j & half) == 0) {
                    const int jl = j & (half - 1), idx = jl * (8 / half);
                    f32x2 d;
                    if (HALF_IN && s == 0) { d = v[j]; }
                    else { const f32x2 a = v[j], b = v[j + half]; v[j] = a + b; d = a - b; }
                    if (SLOG == 0) { v[j + half] = idx == 0 ? d : cmul(d, (f32x2){c16(idx), -s16(idx)}); }
                    else { const f32x2 t = idx == 0 ? wp[s] : cmul(wp[s], (f32x2){c16(idx), -s16(idx)}); v[j + half] = cmul(d, t); } }
            }
        } else {
#pragma unroll
            for (int s = LOGR - 1; s >= 0; --s) {
                const int half = R >> (s + 1);
#pragma unroll
                for (int j = 0; j < R; ++j) if ((j & half) == 0) {
                    const int jl = j & (half - 1), idx = jl * (8 / half);
                    f32x2 b;
                    if (SLOG == 0) { b = idx == 0 ? v[j + half] : cmul(v[j + half], (f32x2){c16(idx), s16(idx)}); }
                    else { const f32x2 t = idx == 0 ? wp[s] : cmul(wp[s], (f32x2){c16(idx), s16(idx)}); b = cmul(v[j + half], t); }
                    const f32x2 a = v[j]; v[j] = a + b; if (!(HALF_OUT && s == 0)) v[j + half] = a - b; }
            }
        }
#pragma unroll
        for (int j = 0; j < (HALF_OUT ? R / 2 : R); ++j) X[fpad(i0 + j * STRIDE)] = v[j];
      }
    }
}
constexpr int TW_A = 0, TW_B = 1024, TW_C = 1024 + 128, TW_N = 1024 + 128 + 16;
__device__ __forceinline__ void fft_build_twiddles(LAS f32x2* TW, int tid) {
    for (int i = tid; i < TW_N; i += NTHR) {
        const int r = i < TW_B ? i : (i < TW_C ? i - TW_B : i - TW_C); const float den = i < TW_B ? (1.0f / 16384.0f) : (i < TW_C ? (1.0f / 1024.0f) : (1.0f / 128.0f));
        float sn, cs; sincospif(-2.0f * (float)r * den, &sn, &cs); TW[i] = (f32x2){cs, sn}; }
}
template <bool HALF_IN>
__device__ __forceinline__ void fft_fwd(LAS f32x2* X, int tid, const LAS f32x2* TW) {
    fft_pass<4, 10, false, HALF_IN>(X, tid, TW + TW_A); __syncthreads(); fft_pass<3, 7, false>(X, tid, TW + TW_B); __syncthreads(); fft_pass<3, 4, false>(X, tid, TW + TW_C); __syncthreads(); fft_pass<4, 0, false>(X, tid, TW); __syncthreads();
}
__device__ __forceinline__ void fft_inv_half(LAS f32x2* X, int tid, const LAS f32x2* TW) {
    fft_pass<4, 0, true>(X, tid, TW); __syncthreads(); fft_pass<3, 4, true>(X, tid, TW + TW_C); __syncthreads(); fft_pass<3, 7, true>(X, tid, TW + TW_B); __syncthreads(); fft_pass<4, 10, true, false, true>(X, tid, TW + TW_A); __syncthreads();
}

constexpr int KT_EARLY = 1280;
template <int PART>
__device__ __forceinline__ void ktime_phase(int layer, unsigned char* lds) {
    const Params p = get_params(); const int bid = BID(), nblk = NBLK(); const int tid = TID();
    LAS float* hT = (LAS float*)lds;
    LAS float* wT = hT + 64 * 132;
    const float* hdn = (const float*)(p.ws + WS_HDN) + (size_t)layer * SEQL * FHID;
    const float* w3 = p.in[10] + (size_t)layer * FHID * 2 * HYW; float* KT = p.out;
    const bool split = (nblk == 256);
    if (PART == 1 && (!split || bid < 128)) return;
    const int first = PART == 1 ? bid - 128 : (PART == 2 && split ? KT_EARLY + bid : bid), step = PART == 1 ? 128 : nblk, lim = PART == 1 ? KT_EARLY : 64 * 32;
    for (int tile = first; tile < lim; tile += step) {
        const int t0 = (tile >> 5) * 128, col0 = (tile & 31) * 64;
        __syncthreads();
        { f32x4 hq[4], wq[2];
#pragma unroll
          for (int q = 0; q < 4; ++q) { const int idx = q * NTHR + tid, tt = idx >> 4, j4 = (idx & 15) * 4;
              hq[q] = *(const f32x4*)(hdn + (size_t)(t0 + tt) * FHID + j4); }
#pragma unroll
          for (int q = 0; q < 2; ++q) { const int idx = q * NTHR + tid, j = idx >> 4, c4 = (idx & 15) * 4; wq[q] = *(const f32x4*)(w3 + (size_t)j * (2 * HYW) + col0 + c4); }
          asm volatile("" : "+v"(hq[0]), "+v"(hq[1]), "+v"(hq[2]), "+v"(hq[3]), "+v"(wq[0]), "+v"(wq[1]));
#pragma unroll
          for (int q = 0; q < 4; ++q) { const int idx = q * NTHR + tid, tt = idx >> 4, j4 = (idx & 15) * 4;
              hT[(j4 + 0) * 132 + tt] = hq[q][0]; hT[(j4 + 1) * 132 + tt] = hq[q][1]; hT[(j4 + 2) * 132 + tt] = hq[q][2]; hT[(j4 + 3) * 132 + tt] = hq[q][3]; }
#pragma unroll
          for (int q = 0; q < 2; ++q) { const int idx = q * NTHR + tid, j = idx >> 4, c4 = (idx & 15) * 4; *(LAS f32x4*)(wT + j * 64 + c4) = wq[q]; } }
        __syncthreads();
        const int tg = (tid & 31) * 4, cg4 = (tid >> 5) * 4;
        f32x4 acc[4] = {{0.f, 0.f, 0.f, 0.f}, {0.f, 0.f, 0.f, 0.f}, {0.f, 0.f, 0.f, 0.f}, {0.f, 0.f, 0.f, 0.f}};
#pragma unroll 8
        for (int j = 0; j < FHID; ++j) { const f32x4 h = *(const LAS f32x4*)(hT + j * 132 + tg), w = *(const LAS f32x4*)(wT + j * 64 + cg4);
            acc[0] += h * w[0]; acc[1] += h * w[1]; acc[2] += h * w[2]; acc[3] += h * w[3]; }
        __syncthreads();
#pragma unroll
        for (int ci = 0; ci < 4; ++ci) { const int c = (col0 + cg4 + ci) & (HYW - 1);
            const float dl = fabsf(-15.350567286626973f + (float)c * ((-3.0701134573253946f + 15.350567286626973f) / 1023.0f));
            f32x4 o;
#pragma unroll
            for (int ti = 0; ti < 4; ++ti) o[ti] = acc[ci][ti] * expf(-((float)(t0 + tg + ti) / (float)(SEQL - 1)) * dl);
            *(LAS f32x4*)(hT + (cg4 + ci) * 132 + tg) = o; }
        __syncthreads();
        { const int col = tid >> 3, ch = (tid & 7) * 16, c = (col0 + col) & (HYW - 1); const bool bwd = col0 >= HYW;
          f32x4 v[4];
#pragma unroll
          for (int q = 0; q < 4; ++q) v[q] = *(const LAS f32x4*)(hT + col * 132 + ch + 4 * q);
          float* dst = KT + (size_t)c * FFTN;
          if (!bwd) {
#pragma unroll
              for (int q = 0; q < 4; ++q) *(f32x4*)(dst + t0 + ch + 4 * q) = v[q];
          } else {
              float* d2 = dst + (2 * SEQL - 16) - (t0 + ch);
#pragma unroll
              for (int q = 0; q < 4; ++q) *(f32x4*)(d2 + 4 * q) = (f32x4){v[3 - q][3], v[3 - q][2], v[3 - q][1], v[3 - q][0]};
          } }
    }
}

__device__ __forceinline__ void fft_conv_phase(int layer, unsigned char* lds) {
    const Params p = get_params(); const int bid = BID(), nblk = NBLK();
    LAS f32x2* X = (LAS f32x2*)lds; LAS float* RED = (LAS float*)(lds + FFT_LDS);
    const int tid0 = TID(), wid = tid0 >> 6, lane = tid0 & 63;
    const float* skip = p.in[12] + layer * HYW; const float* KT = p.out;
    const float* Z = (const float*)(p.ws + WS_Z); const bf16_t* X0T = (const bf16_t*)(p.ws + WS_X0T);
    LAS f32x2* T = (LAS f32x2*)(lds + FFT_LDS + 1024);
    fft_build_twiddles(T, tid0);
    for (int c = bid; c < HYW; c += nblk) {
        __syncthreads();
        const int tid = lv(tid0);
        const float* kt = KT + (size_t)c * FFTN;
        float asum = 0.f;
        { float kv[32];
#pragma unroll
          for (int q = 0; q < 32; ++q) kv[q] = kt[q * NTHR + tid];
          PIN16F(kv, 0); PIN16F(kv, 16);
#pragma unroll
          for (int q = 0; q < 32; ++q) { asum += fabsf(kv[q]); X[fpad(q * NTHR + tid)] = (f32x2){kv[q], 0.f}; } }
#pragma unroll
        for (int o = 32; o > 0; o >>= 1) asum += __shfl_xor(asum, o);
        if (lane == 0) RED[wid] = asum;
        __syncthreads();
        float total = 0.f;
#pragma unroll
        for (int i = 0; i < 8; ++i) total += RED[i];
        fft_fwd<false>(X, tid, T);
        const float scale = 1.0f / ((float)FFTN * total);
        f32x2 kreg[32];
#pragma unroll
        for (int q = 0; q < 32; ++q) kreg[q] = X[fpad(q * NTHR + tid)] * scale;
        __syncthreads();
        const float* z0 = Z + (size_t)c * 2 * SEQL; const float* z1 = z0 + SEQL;
        { float za[16], zb[16];
#pragma unroll
          for (int q = 0; q < 16; ++q) { za[q] = z0[q * NTHR + tid]; zb[q] = z1[q * NTHR + tid]; }
          PIN16F(za, 0); PIN16F(zb, 0);
#pragma unroll
          for (int q = 0; q < 16; ++q) X[fpad(q * NTHR + tid)] = (f32x2){za[q], zb[q]}; }
        __syncthreads();
        fft_fwd<true>(X, tid, T);
#pragma unroll
        for (int q = 0; q < 32; ++q) { const int i = fpad(q * NTHR + tid); X[i] = cmul(X[i], kreg[q]); }
        __syncthreads();
        fft_inv_half(X, tid, T);
        const float sk = skip[c];
        const bf16_t* x00 = X0T + (size_t)c * 2 * SEQL; const bf16_t* x01 = x00 + SEQL;
        bf16_t* yt0 = (bf16_t*)(p.ws + WS_YT) + (size_t)c * 2 * SEQL; bf16_t* yt1 = yt0 + SEQL;
#pragma unroll
        for (int hq = 0; hq < 2; ++hq) {
            float za[8], zb[8]; unsigned xa[8], xb[8];
#pragma unroll
            for (int q = 0; q < 8; ++q) { const int t = (hq * 8 + q) * NTHR + tid; za[q] = z0[t]; zb[q] = z1[t]; xa[q] = x00[t]; xb[q] = x01[t]; }
            asm volatile("" : "+v"(za[0]), "+v"(za[1]), "+v"(za[2]), "+v"(za[3]), "+v"(za[4]), "+v"(za[5]), "+v"(za[6]), "+v"(za[7]), "+v"(zb[0]), "+v"(zb[1]), "+v"(zb[2]), "+v"(zb[3]), "+v"(zb[4]), "+v"(zb[5]), "+v"(zb[6]), "+v"(zb[7]));
            asm volatile("" : "+v"(xa[0]), "+v"(xa[1]), "+v"(xa[2]), "+v"(xa[3]), "+v"(xa[4]), "+v"(xa[5]), "+v"(xa[6]), "+v"(xa[7]), "+v"(xb[0]), "+v"(xb[1]), "+v"(xb[2]), "+v"(xb[3]), "+v"(xb[4]), "+v"(xb[5]), "+v"(xb[6]), "+v"(xb[7]));
#pragma unroll
            for (int q = 0; q < 8; ++q) { const int t = (hq * 8 + q) * NTHR + tid;
                const f32x2 y = X[fpad(t)];
                const float ya = __uint_as_float(xa[q] << 16) * (y.x + sk * za[q]), yb = __uint_as_float(xb[q] << 16) * (y.y + sk * zb[q]);
                yt0[t] = (bf16_t)(pk_bf16(ya, ya) & 0xffffu);
                yt1[t] = (bf16_t)(pk_bf16(yb, yb) & 0xffffu); }
        }
    }
}

__device__ __forceinline__ void ytrans_phase(unsigned char* lds) {
    const Params p = get_params(); const int bid = BID(), nblk = NBLK(); const int tid = TID();
    LAS float* T = (LAS float*)lds; constexpr int TS = 64 * 65, NT = 16 * 256;
    const bf16_t* YT = (const bf16_t*)(p.ws + WS_YT); bf16_t* YHY = (bf16_t*)(p.ws + WS_YHY);
    for (int id0 = bid; id0 < NT; id0 += 4 * nblk) {
        u32x4 w[4];
#pragma unroll
        for (int q = 0; q < 4; ++q) { const int id = id0 + q * nblk; if (id < NT) { const int t0 = (id >> 4) * 64, c0 = (id & 15) * 64, cc = tid >> 3, t8 = (tid & 7) * 8;
            w[q] = *(const u32x4*)(YT + ((size_t)(c0 + cc) * 2 + (t0 >> 13)) * SEQL + (t0 & (SEQL - 1)) + t8); } }
#pragma unroll
        for (int q = 0; q < 4; ++q) { const int id = id0 + q * nblk; if (id < NT) { const int cc = tid >> 3, t8 = (tid & 7) * 8; LAS float* d = T + q * TS + t8 * 65 + cc;
            d[0] = bf_lo(w[q].x); d[65] = bf_hi(w[q].x); d[130] = bf_lo(w[q].y); d[195] = bf_hi(w[q].y); d[260] = bf_lo(w[q].z); d[325] = bf_hi(w[q].z); d[390] = bf_lo(w[q].w); d[455] = bf_hi(w[q].w); } }
        __syncthreads();
#pragma unroll
        for (int q = 0; q < 4; ++q) { const int id = id0 + q * nblk; if (id < NT) { const int t0 = (id >> 4) * 64, c0 = (id & 15) * 64, tt = tid >> 3, c8 = (tid & 7) * 8; const LAS float* sp = T + q * TS + tt * 65 + c8;
            u32x4 o; o.x = pk_bf16(sp[0], sp[1]); o.y = pk_bf16(sp[2], sp[3]); o.z = pk_bf16(sp[4], sp[5]); o.w = pk_bf16(sp[6], sp[7]);
            *(u32x4*)(YHY + (size_t)(t0 + tt) * HYW + c0 + c8) = o; } }
        __syncthreads();
    }
}

__device__ __forceinline__ void attention_phase(unsigned char* lds) {
    const Params p = get_params(); const int bid = BID(), nblk = NBLK();
    const att::bf16* QKV = (const att::bf16*)(p.ws + WS_QKV); att::bf16* YAT = (att::bf16*)(p.ws + WS_YAT);
    for (int item = bid; item < NB * NH * (SEQL / 256); item += nblk) {
        const int b = item >> 8, h = (item >> 5) & 7, qb = item & 31, kvh = h >> 2;
        const att::bf16* Q = QKV + ((size_t)b * SEQL + qb * 256) * 1536 + h * HD;
        const att::bf16* K = QKV + ((size_t)b * SEQL) * 1536 + QW + kvh * HD;
        const att::bf16* V = K + KVW;
        att::bf16* O = YAT + ((size_t)b * SEQL + qb * 256) * QW + h * HD;
        __syncthreads();
        att::attn_dense_body<att::bf16>(Q, K, V, O, SEQL, (char*)lds);
    }
    __syncthreads();
}

#define XB_TMO      128
#define XB_XCNT(j)  (256  + 64 * (j))
#define XB_XSUB(j)  (1280 + 64 * (j))
#define XB_XGEN(j)  (2304 + 64 * (j))
#define XB_TOP      3328
#define XB_TOPGEN   3392
#define XCD_BAR_WORDS 3456
#define XB_SPIN_CAP (1u << 18)

__device__ __forceinline__ unsigned xb_ld(unsigned* p)              { return __hip_atomic_load(p, __ATOMIC_RELAXED, __HIP_MEMORY_SCOPE_AGENT); }
__device__ __forceinline__ unsigned xb_add(unsigned* p, unsigned v) { return __hip_atomic_fetch_add(p, v, __ATOMIC_RELAXED, __HIP_MEMORY_SCOPE_AGENT); }
__device__ __forceinline__ unsigned xb_xcc_id() { return (unsigned)__builtin_amdgcn_s_getreg((3 << 11) | 20) & 0xFu; }
#define XB_SPIN(cond, bar) do { unsigned _sp = 0; while (cond) { __builtin_amdgcn_s_sleep(1); \
    if ((++_sp & 255u) == 0u) { if (xb_ld(&(bar)[XB_TMO])) break; if (_sp > XB_SPIN_CAP) { atomicAdd(&(bar)[XB_TMO], 1u); break; } } } } while (0)

struct XcdBarrier {
    unsigned* bar; unsigned x;
    volatile LAS unsigned* st;
};

__device__ __forceinline__ XcdBarrier xcd_barrier_post(unsigned* bar, volatile LAS unsigned* st) {
    XcdBarrier b; b.bar = bar; b.x = xb_xcc_id(); b.st = st;
    if (threadIdx.x == 0) (void)xb_add(&bar[XB_XCNT(b.x)], 1u);
    return b;
}
__device__ __forceinline__ void xcd_barrier_complete(unsigned* bar, unsigned x, unsigned& nloc, unsigned& nx) {
    const unsigned G = gridDim.x * gridDim.y * gridDim.z;
    unsigned sum, cnt, mine, sp = 0u;
    for (;;) {
        sum = 0u; cnt = 0u; mine = 0u;
#pragma unroll
        for (unsigned j = 0; j < 16; ++j) { const unsigned c = xb_ld(&bar[XB_XCNT(j)]); sum += c; cnt += (c > 0u) ? 1u : 0u; mine = (j == x) ? c : mine; }
        if (sum == G) break;
        __builtin_amdgcn_s_sleep(1);
        if ((++sp & 255u) == 0u) { if (xb_ld(&bar[XB_TMO])) break; if (sp > XB_SPIN_CAP) { atomicAdd(&bar[XB_TMO], 1u); break; } }
    }
    nloc = mine > 0u ? mine : 1u; nx = cnt > 0u ? cnt : 1u;
}

__device__ __forceinline__ void xcd_barrier(const XcdBarrier& b) {
    asm volatile("s_waitcnt vmcnt(0)" ::: "memory");
    __syncthreads();
    if (threadIdx.x == 0) {
        unsigned* bar = b.bar;
        __builtin_amdgcn_s_waitcnt(0);
        unsigned nloc = b.st[0], nx = b.st[1];
        if (nloc == 0u) { xcd_barrier_complete(bar, b.x, nloc, nx); b.st[0] = nloc; b.st[1] = nx; }
        const unsigned old = xb_add(&bar[XB_XSUB(b.x)], 1u);
        const unsigned gen = old / nloc;
        if (old + 1u == (gen + 1u) * nloc) {
            __builtin_amdgcn_fence(__ATOMIC_RELEASE, "agent");
            asm volatile("s_waitcnt vmcnt(0)" ::: "memory");
            const unsigned og = xb_add(&bar[XB_TOP], 1u);
            const unsigned tg = og / nx;
            if (og + 1u == (tg + 1u) * nx) xb_add(&bar[XB_TOPGEN], 1u);
            else XB_SPIN(xb_ld(&bar[XB_TOPGEN]) == tg, bar);
            __builtin_amdgcn_fence(__ATOMIC_ACQUIRE, "agent");
            xb_add(&bar[XB_XGEN(b.x)], 1u);
            asm volatile("s_waitcnt vmcnt(0)" ::: "memory");
        } else {
            XB_SPIN(xb_ld(&bar[XB_XGEN(b.x)]) == gen, bar);
            __builtin_amdgcn_fence(__ATOMIC_ACQUIRE, "agent");
            asm volatile("s_waitcnt vmcnt(0)" ::: "memory");
        }
    }
    __syncthreads();
}
__device__ __forceinline__ LnFold make_fold(const Params& p, int sid, int gi, int bi, int glayer, bool is_in) {
    LnFold f; f.stats = sid < 0 ? nullptr : (const float*)(p.ws + WS_STATS) + (size_t)sid * NTOK * 2;
    f.g = p.in[gi] + (size_t)glayer * DM; f.b = p.in[bi] + (size_t)glayer * DM;
    f.pu = (const float*)(p.ws + (is_in ? WS_PUIN : WS_PUUP)); f.pv = (const float*)(p.ws + (is_in ? WS_PVIN : WS_PVUP)); return f;
}
constexpr size_t OUT_RB = (size_t)NTOK * DM * 2;
template <int MODE>
__device__ __forceinline__ void gemm_step(unsigned char* lds, int a_sel, size_t a_off, size_t b_off, int N, int K, int o_sel, size_t o_off, int ldc, int g_sel, size_t g_off, int gofs,
                                          int sid, int gi, int bi, int glayer, bool is_in, int sid_out) {
    const Params p = get_params(); unsigned char* ws = p.ws; unsigned char* od = (unsigned char*)p.out;
    EpiX<MODE> E{(bf16_t*)((o_sel ? od : ws) + o_off), ldc, (bf16_t*)(ws + WS_QKV), (bf16_t*)(ws + WS_G), (const bf16_t*)((g_sel ? od : ws) + g_off), gofs,
                 make_fold(p, sid, gi, bi, glayer, is_in), sid_out < 0 ? nullptr : (float*)(ws + WS_STATS) + (size_t)sid_out * NTOK * 2};
    const bf16_t* A = (const bf16_t*)((a_sel ? od : ws) + a_off);
    if constexpr (MODE == 6) run_gemm<MODE>(lds, A, (const bf16_t*)(ws + b_off), N, K, E, (const bf16_t*)(ws + WS_YAT), (const bf16_t*)(ws + WS_WAT));
    else run_gemm<MODE>(lds, A, (const bf16_t*)(ws + b_off), N, K, E);
}
#define GRID_BAR() xcd_barrier(xbar)
__global__ void __launch_bounds__(NTHR) hyena_gqa_mega(Params p_unused) {
    extern __shared__ __attribute__((aligned(16))) unsigned char lds[];
    cg::grid_group grid = cg::this_grid();

    volatile LAS unsigned* xst = (volatile LAS unsigned*)(lds + XST_OFF);
    if (threadIdx.x < 2) xst[threadIdx.x] = 0u;
    { const Params p = get_params();
      if (blockIdx.x == 0) { unsigned* bw = (unsigned*)(p.ws + WS_BAR); for (int i = threadIdx.x; i < XCD_BAR_WORDS; i += NTHR) bw[i] = 0u; }
      float* st = (float*)(p.ws + WS_STATS); for (int i = blockIdx.x * NTHR + threadIdx.x; i < 3 * NTOK * 2; i += gridDim.x * NTHR) st[i] = 0.f; }
    for (int rep = 0; rep < REP_CONV; ++rep) convert_weights_phase(0, lds);
    ln_phase<0>(1, 2, 0);
    hdn_phase(lds);
    grid.sync();
    XcdBarrier xbar;
    { const Params p = get_params(); xbar = xcd_barrier_post((unsigned*)(p.ws + WS_BAR), xst); }

#pragma nounroll
    for (int layer = 0; layer < DEPTH; ++layer) {
        const int sid_in = layer == 0 ? -1 : 1, sid_mid = layer == 0 ? 0 : 2, lprev = layer == 0 ? 0 : layer - 1;
        for (int rep = 0; rep < REP_PROJ; ++rep) gemm_step<0>(lds, 0, WS_HB, WS_WIN, NIN, DM, 0, WS_PH, 3072, 0, WS_G, 0, sid_in, 22, 23, lprev, true, -1);
        ktime_phase<1>(layer, lds);
        GRID_BAR();
        for (int rep = 0; rep < REP_HPRE; ++rep) hyena_pre_phase(layer, lds);
        qk_rope_phase(layer);
        for (int rep = 0; rep < REP_KT; ++rep) ktime_phase<2>(layer, lds);
        GRID_BAR();
        for (int rep = 0; rep < REP_FFT; ++rep) fft_conv_phase(layer, lds);
        for (int rep = 0; rep < REP_ATT; ++rep) attention_phase(lds);
        GRID_BAR();
        ytrans_phase(lds);
        GRID_BAR();
        for (int rep = 0; rep < REP_P4; ++rep) gemm_step<6>(lds, 0, WS_YHY, WS_WHY, DM, HYW, 0, WS_MRG, DM, 0, WS_G, DM, -1, 22, 23, 0, true, -1);
        GRID_BAR();
        for (int rep = 0; rep < REP_WO; ++rep) gemm_step<5>(lds, 0, WS_MRG, WS_WO, DM, DM, 0, WS_RB, DM, 0, WS_HB, 0, sid_in, 22, 23, lprev, true, sid_mid);
        GRID_BAR();
        for (int rep = 0; rep < REP_UP; ++rep) gemm_step<4>(lds, 0, WS_RB, WS_WUP, DFF, DM, 0, WS_FF, DFF, 0, WS_G, 0, sid_mid, 18, 19, layer, false, -1);
        GRID_BAR();
        for (int rep = 0; rep < REP_DOWN; ++rep) gemm_step<5>(lds, 0, WS_FF, WS_WDN, DM, DFF, 0, WS_HB, DM, 0, WS_RB, 0, sid_mid, 18, 19, layer, false, layer + 1 < DEPTH ? 1 : -1);
        GRID_BAR();
        if (layer + 1 < DEPTH) { convert_weights_phase(layer + 1, lds); GRID_BAR(); }
        else ln_phase<2>(22, 23, layer);
    }
}

extern "C" void kernel_launch(void* const* d_in, const int* in_sizes, int n_in, void* d_out, int out_size, void* d_ws, size_t ws_size, hipStream_t stream) {
    static int grid_blocks = 0;
    if (grid_blocks == 0) {
        if (n_in != 24 || out_size != NTOK * DM || ws_size < WS_END) { fprintf(stderr, "kernel_launch: unexpected shapes (n_in %d out %d ws %zu need %zu)\n", n_in, out_size, ws_size, (size_t)WS_END); grid_blocks = -1; return; }
        int dev = 0, cus = 0, per_cu = 0;
        hipGetDevice(&dev); hipDeviceGetAttribute(&cus, hipDeviceAttributeMultiprocessorCount, dev);
        if (hipFuncSetAttribute((const void*)hyena_gqa_mega, hipFuncAttributeMaxDynamicSharedMemorySize, LDS_BYTES) != hipSuccess) { fprintf(stderr, "kernel_launch: hipFuncSetAttribute failed\n"); grid_blocks = -1; return; }
        hipOccupancyMaxActiveBlocksPerMultiprocessor(&per_cu, (const void*)hyena_gqa_mega, NTHR, LDS_BYTES);
        if (per_cu < 1) { fprintf(stderr, "kernel_launch: occupancy query says 0 blocks/CU\n"); per_cu = 1; }
        grid_blocks = cus * per_cu;
    }
    if (grid_blocks < 0) return;
    Params p{};
    for (int i = 0; i < 24; ++i) p.in[i] = (const float*)d_in[i];
    p.out = (float*)d_out; p.ws = (unsigned char*)d_ws;
    void* args[] = {&p};
    hipError_t e = hipLaunchCooperativeKernel((const void*)hyena_gqa_mega, dim3(grid_blocks), dim3(NTHR), args, LDS_BYTES, stream);
    if (e != hipSuccess) fprintf(stderr, "cooperative launch failed: %s (grid %d)\n", hipGetErrorString(e), grid_blocks);
}
```

```cpp
#include <hip/hip_runtime.h>
#include <hip/hip_bf16.h>
#include <hip/hip_cooperative_groups.h>
#include <cstdio>
#include <cstdint>
namespace cg = cooperative_groups;

constexpr int DM = 2048, NB = 2, SEQL = 8192, NTOK = NB * SEQL, DEPTH = 2, GRIDW = 64;
constexpr int HYW = 1024, FEMB = 33, FHID = 64, HD = 128, NH = 8, NKV = 2, QW = 1024, KVW = 256, DFF = 8192, NIN = 8704;
constexpr float ALPHA_F = 1.4142135623730951f;
constexpr float LN_EPS = 1e-5f, RMS_EPS = 1e-6f;
constexpr int NTHR = 512;
#ifndef WGM_WIDE
#define WGM_WIDE 8
#endif
#ifndef WGM_NARROW
#define WGM_NARROW 2
#endif

#ifndef REP_FFT
#define REP_FFT 1
#endif
#ifndef REP_ATT
#define REP_ATT 1
#endif
#ifndef REP_PROJ
#define REP_PROJ 1
#endif
#ifndef REP_CONV
#define REP_CONV 1
#endif
#ifndef REP_HPRE
#define REP_HPRE 1
#endif
#ifndef REP_UP
#define REP_UP 1
#endif
#ifndef REP_SYNC
#define REP_SYNC 1
#endif
#ifndef REP_FOUT
#define REP_FOUT 1
#endif
#ifndef REP_KT
#define REP_KT 1
#endif
#ifndef REP_DOWN
#define REP_DOWN 1
#endif
#ifndef REP_WO
#define REP_WO 1
#endif
#ifndef REP_P4
#define REP_P4 1
#endif
#ifndef REP_LN0
#define REP_LN0 1
#endif
#ifndef REP_HDN
#define REP_HDN 1
#endif


namespace pg8 {
#define PG8_LAS __attribute__((address_space(3)))
typedef unsigned short bf16_t;
typedef short bf16x8 __attribute__((ext_vector_type(8)));
typedef float f32x4 __attribute__((ext_vector_type(4)));
typedef unsigned u32x4 __attribute__((ext_vector_type(4)));
constexpr int BM = 256, BK = 64, HALF = 128, HTB = HALF * BK * 2  , STAGE_BYTES = 8 * HTB, NXCD = 8;

__host__ __device__ __forceinline__ int lds_byte(int r, int c) { const int st = (r >> 4) * 2 + (c >> 5), rr = r & 15, cc = c & 31, ob = rr * 64 + cc * 2; return st * 1024 + (ob ^ (((ob >> 9) & 1) << 5)); }
__host__ __device__ __forceinline__ void stage_rc(int b, int& R, int& C) { const int st = b / 1024, sb = b % 1024, swz = sb ^ (((sb >> 9) & 1) << 5); R = (st >> 1) * 16 + swz / 64; C = (st & 1) * 32 + (swz % 64) / 2; }
__host__ __device__ __forceinline__ int perm32(int rho) { const int n = rho >> 4, i = rho & 15; return 8 * (i >> 2) + 4 * n + (i & 3); }

struct Unit { int pm, pn; };
struct Gemm { const bf16_t* A; const bf16_t* Bt; int M, N, K; const bf16_t* A2; const bf16_t* Bt2; };

struct StaticOrder {
    int nM, nN, nwg, G, c, WGM;
    __host__ __device__ void init(int M, int N, int G_, int c_, int wgm) { nM = M / BM; nN = N / BM; nwg = nM * nN; G = G_; c = c_; WGM = wgm; }
    __host__ __device__ bool next(int i, Unit& u) const {
        const long L = (long)i * G + c; if (L >= nwg) return false;
        int wgid = (int)L; { const int q = nwg / NXCD, r = nwg % NXCD, xcd = wgid % NXCD, off = wgid / NXCD; wgid = (xcd < r ? xcd * (q + 1) : r * (q + 1) + (xcd - r) * q) + off; }
        const int nig = WGM * nN, gid = wgid / nig, fm = gid * WGM, gsz = (nM - fm) < WGM ? (nM - fm) : WGM;
        u.pm = fm + ((wgid % nig) % gsz); u.pn = (wgid % nig) / gsz; return true;
    }
    __device__ __forceinline__ void a_ready(const Unit&) const {}
    __device__ __forceinline__ void done(const Unit&) const {}
};
__device__ __forceinline__ unsigned cvt_pk_bf16(float lo, float hi) { unsigned r; asm volatile("v_cvt_pk_bf16_f32 %0, %1, %2" : "=v"(r) : "v"(lo), "v"(hi)); return r; }
template <class Epi, class Sched, bool DUAL = false>
__device__ __forceinline__ void gemm_phase(PG8_LAS unsigned char* lds, const Gemm g, const Sched& S, const Epi& E) {
    int tid_ = threadIdx.x; asm volatile("" : "+v"(tid_)); const int tid = tid_, wid = __builtin_amdgcn_readfirstlane(tid >> 6), lane = tid & 63, wr = wid >> 2, wc = wid & 3, fr = lane & 15, fq = lane >> 4;
    const int K = g.K, nt = K / BK;
    unsigned voffA[2], voffB[2];
#pragma unroll
    for (int i = 0; i < 2; ++i) { int R, C; stage_rc(tid * 16 + i * 8192, R, C); const int Rb = Epi::PERM ? ((R & ~31) + perm32(R & 31)) : R;
        voffA[i] = (unsigned)(R * K + C) * 2u; voffB[i] = (unsigned)(Rb * K + C) * 2u; }
    const size_t kstep = (size_t)(BK * 2);
    const size_t hstep = (size_t)HALF * K * 2;
    const size_t tstep = 2 * hstep;
    const unsigned ldsw = (unsigned)wid * 1024u;
    const int aoff = lds_byte(wr * 64 + fr, fq * 8), boff = lds_byte(wc * 32 + fr, fq * 8);
#define PG8_SA(b, h) (((b) * 2 + (h)) * HTB)
#define PG8_SB(b, h) ((4 + (b) * 2 + (h)) * HTB)
#define PG8_STAGE(bufoff, gbase, voff) do { _Pragma("unroll") for (int _i = 0; _i < 2; ++_i) \
        __builtin_amdgcn_global_load_lds((const unsigned*)((const char*)(gbase) + (voff)[_i]), (PG8_LAS unsigned*)(lds + (bufoff) + ldsw + _i * 8192), 16, 0, 0); } while (0)
#define PG8_LDA(dst, b, h) do { _Pragma("unroll") for (int m = 0; m < 4; ++m) _Pragma("unroll") for (int k = 0; k < 2; ++k) dst[m][k] = *(const PG8_LAS bf16x8*)(lds + PG8_SA(b, h) + aoff + m * 2048 + k * 1024); } while (0)
#define PG8_LDB(dst, b, h) do { _Pragma("unroll") for (int n = 0; n < 2; ++n) _Pragma("unroll") for (int k = 0; k < 2; ++k) dst[n][k] = *(const PG8_LAS bf16x8*)(lds + PG8_SB(b, h) + boff + n * 2048 + k * 1024); } while (0)
#define PG8_MMA(ai, bj, At, Bt) do { __builtin_amdgcn_s_setprio(1); _Pragma("unroll") for (int m = 0; m < 4; ++m) _Pragma("unroll") for (int n = 0; n < 2; ++n) _Pragma("unroll") for (int k = 0; k < 2; ++k) \
        acc[ai][bj][m][n] = __builtin_amdgcn_mfma_f32_16x16x32_bf16(Bt[n][k], At[m][k], acc[ai][bj][m][n], 0, 0, 0); __builtin_amdgcn_s_setprio(0); } while (0)
#define PG8_WAIT_V(n) asm volatile("s_waitcnt vmcnt(" #n ")" ::: "memory")
#define PG8_WAIT_L(n) asm volatile("s_waitcnt lgkmcnt(" #n ")" ::: "memory")
#define PG8_BAR __builtin_amdgcn_s_barrier()
#define PG8_SCHED __builtin_amdgcn_sched_barrier(0)
    Unit cur, nxt; int ui = 0;
    if (!S.next(0, cur)) return;
    f32x4 acc[2][2][4][2];
#pragma unroll
    for (int a = 0; a < 2; ++a)
#pragma unroll
        for (int b = 0; b < 2; ++b)
#pragma unroll
            for (int m = 0; m < 4; ++m)
#pragma unroll
                for (int n = 0; n < 2; ++n) acc[a][b][m][n] = (f32x4){0.f, 0.f, 0.f, 0.f};
    bf16x8 At[4][2], B0[2][2], B1[2][2];
    const char* cA = (const char*)g.A + (size_t)cur.pm * tstep; const char* cB = (const char*)g.Bt + (size_t)cur.pn * tstep;
    S.a_ready(cur);
    PG8_STAGE(PG8_SB(0, 0), cB, voffB); PG8_STAGE(PG8_SA(0, 0), cA, voffA); PG8_STAGE(PG8_SB(0, 1), cB + hstep, voffB); PG8_STAGE(PG8_SA(0, 1), cA + hstep, voffA);
    if (wr == 1) PG8_BAR;
    PG8_WAIT_V(4); PG8_BAR;
    PG8_STAGE(PG8_SB(1, 0), cB + kstep, voffB); PG8_STAGE(PG8_SA(1, 0), cA + kstep, voffA); PG8_STAGE(PG8_SB(1, 1), cB + hstep + kstep, voffB);
    PG8_WAIT_V(6); PG8_BAR;
    const char* cA2 = DUAL ? (const char*)g.A2 + (size_t)cur.pm * tstep : cA; const char* cB2 = DUAL ? (const char*)g.Bt2 + (size_t)cur.pn * tstep : cB;
    const int ntt = DUAL ? 2 * nt : nt;
    for (;;) {
        const bool has_next = S.next(ui + 1, nxt);
        const char* nA = has_next ? (const char*)g.A + (size_t)nxt.pm * tstep : cA; const char* nB = has_next ? (const char*)g.Bt + (size_t)nxt.pn * tstep : cB;
        for (int t = 0; t < ntt; t += 2) {
            const bool last = (t == ntt - 2);
            const bool s1 = DUAL && (t + 1 >= nt), s2 = DUAL && (t + 2 >= nt);
            const char* a1 = (s1 ? cA2 + (size_t)(t + 1 - nt) * kstep : cA + (size_t)(t + 1) * kstep);
            const char* a2 = last ? nA : (s2 ? cA2 + (size_t)(t + 2 - nt) * kstep : cA + (size_t)(t + 2) * kstep);
            const char* b2 = last ? nB : (s2 ? cB2 + (size_t)(t + 2 - nt) * kstep : cB + (size_t)(t + 2) * kstep);
            const char* a3 = a2 + kstep; const char* b3 = b2 + kstep;
            if (last && has_next) S.a_ready(nxt);
            PG8_LDB(B0, 0, 0); PG8_SCHED; PG8_LDA(At, 0, 0); PG8_STAGE(PG8_SA(1, 1), a1 + hstep, voffA);
            PG8_WAIT_L(8); PG8_BAR; PG8_WAIT_L(0); PG8_MMA(0, 0, At, B0); PG8_BAR; PG8_SCHED;
            PG8_LDB(B1, 0, 1); PG8_STAGE(PG8_SB(0, 0), b2, voffB);
            PG8_BAR; PG8_WAIT_L(0); PG8_MMA(0, 1, At, B1); PG8_BAR;
            PG8_LDA(At, 0, 1); PG8_STAGE(PG8_SA(0, 0), a2, voffA);
            PG8_BAR; PG8_WAIT_L(0); PG8_MMA(1, 0, At, B0); PG8_BAR; PG8_SCHED;
            PG8_STAGE(PG8_SB(0, 1), b2 + hstep, voffB);
            PG8_WAIT_V(6); PG8_BAR; PG8_MMA(1, 1, At, B1); PG8_BAR;
            PG8_LDB(B0, 1, 0); PG8_SCHED; PG8_LDA(At, 1, 0); PG8_STAGE(PG8_SA(0, 1), a2 + hstep, voffA);
            PG8_WAIT_L(8); PG8_BAR; PG8_WAIT_L(0); PG8_MMA(0, 0, At, B0); PG8_BAR; PG8_SCHED;
            PG8_LDB(B1, 1, 1); PG8_STAGE(PG8_SB(1, 0), b3, voffB);
            PG8_BAR; PG8_WAIT_L(0); PG8_MMA(0, 1, At, B1); PG8_BAR;
            PG8_LDA(At, 1, 1); PG8_STAGE(PG8_SA(1, 0), a3, voffA);
            PG8_BAR; PG8_WAIT_L(0); PG8_MMA(1, 0, At, B0); PG8_BAR; PG8_SCHED;
            PG8_STAGE(PG8_SB(1, 1), b3 + hstep, voffB);
            PG8_WAIT_V(6); PG8_BAR; PG8_MMA(1, 1, At, B1); PG8_BAR;
            if constexpr (DUAL) { if (t == nt - 2) E.mid(acc, cur, wr, wc, fr, fq); }
        }
        if constexpr (!Epi::AFTER_DRAIN) { E(acc, cur, wr, wc, fr, fq); S.done(cur); }
        if (!has_next) break;
#pragma unroll
        for (int a = 0; a < 2; ++a)
#pragma unroll
            for (int b = 0; b < 2; ++b)
#pragma unroll
                for (int m = 0; m < 4; ++m)
#pragma unroll
                    for (int n = 0; n < 2; ++n) acc[a][b][m][n] = (f32x4){0.f, 0.f, 0.f, 0.f};
        cur = nxt; cA = nA; cB = nB; ++ui;
        if (DUAL) { cA2 = (const char*)g.A2 + (size_t)cur.pm * tstep; cB2 = (const char*)g.Bt2 + (size_t)cur.pn * tstep; }
    }
    PG8_WAIT_V(0);
    if (wr == 0) PG8_BAR;
    PG8_BAR;
    if constexpr (Epi::AFTER_DRAIN) { E.fused(acc, cur, wr, wc, fr, fq, lds, wid, lane); S.done(cur); }
#undef PG8_SA
#undef PG8_SB
#undef PG8_STAGE
#undef PG8_LDA

#undef PG8_LDB
#undef PG8_MMA
#undef PG8_WAIT_V
#undef PG8_WAIT_L
#undef PG8_BAR
#undef PG8_SCHED
}
}
namespace att {
using bf16 = __hip_bfloat16;
constexpr int   D = 128, NW = 8, QBLK = 32, KVBLK = 64;
constexpr float SCALE = 0.088388347648318440f;
constexpr float THR = 8.f;
constexpr int SDEPTH = 2;
constexpr int LDQ = 1536, LDK = 1536, LDO = 1024;
constexpr size_t SHM_V = KVBLK * D * 2, SHM_K = KVBLK * D * 2, SHM_ATTN = 2 * SHM_V + 2 * SHM_K + NW * 64 * 4;
using u32x4  = __attribute__((ext_vector_type(4))) unsigned;

using bf16x8 = __attribute__((ext_vector_type(8))) short;
using s16x4  = __attribute__((ext_vector_type(4))) short;
using f32x16 = __attribute__((ext_vector_type(16))) float;
using f32x8  = __attribute__((ext_vector_type(8))) float;
#define KSWZ(row, colB) ((row) * 256 + ((colB) ^ (((row) & 7) << 4)))
#define SBAR() __builtin_amdgcn_sched_barrier(0)
__device__ __forceinline__ int crow(int r, int hi) { return (r & 3) + 8 * (r >> 2) + 4 * hi; }
__device__ __forceinline__ unsigned cvtpk(float lo, float hi) {
  unsigned r; asm volatile("v_cvt_pk_bf16_f32 %0, %1, %2" : "=v"(r) : "v"(lo), "v"(hi)); return r;
}
template <typename TIn> struct Stage;
template <> struct Stage<bf16>  { using T = bf16x8;
  __device__ static __forceinline__ T ld8(const bf16* p) { return *reinterpret_cast<const bf16x8*>(p); }
  __device__ static __forceinline__ bf16x8 tobf(T x) { return x; } };
template <> struct Stage<float> { using T = f32x8;
  __device__ static __forceinline__ T ld8(const float* p) { return *reinterpret_cast<const f32x8*>(p); }
  __device__ static __forceinline__ bf16x8 tobf(T x) {
    u32x4 w = {cvtpk(x[0], x[1]), cvtpk(x[2], x[3]), cvtpk(x[4], x[5]), cvtpk(x[6], x[7])}; return *reinterpret_cast<bf16x8*>(&w); } };

__device__ __forceinline__ void partialSM(f32x16& p0, f32x16& p1, float& m_reg, float& mn, float& alpha) {
  constexpr float C = SCALE * 1.4426950408889634f;
  float pmax = p0[0]; for (int r = 1; r < 16; ++r) pmax = fmaxf(pmax, p0[r]); for (int r = 0; r < 16; ++r) pmax = fmaxf(pmax, p1[r]);
  { auto rr = __builtin_amdgcn_permlane32_swap(__float_as_uint(pmax), __float_as_uint(pmax), false, false);
    pmax = fmaxf(__uint_as_float(rr[0]), __uint_as_float(rr[1])); }
  if (__builtin_expect(__all(pmax - m_reg <= THR / SCALE), 1)) { mn = m_reg; alpha = 1.f; }
  else { mn = fmaxf(m_reg, pmax); alpha = __builtin_amdgcn_exp2f((m_reg - mn) * C); m_reg = mn; }
  float mnC = -mn * C;
  for (int r = 0; r < 16; ++r) p0[r] = fmaf(p0[r], C, mnC); for (int r = 0; r < 16; ++r) p1[r] = fmaf(p1[r], C, mnC);
  for (int r = 0; r < 16; ++r) p0[r] = __builtin_amdgcn_exp2f(p0[r]);
}
__device__ __forceinline__ void finishSM(f32x16& p0, f32x16& p1, float alpha, float& l_reg, bf16x8& pa0, bf16x8& pa1, bf16x8& pa2, bf16x8& pa3) {
  for (int r = 0; r < 16; ++r) p1[r] = __builtin_amdgcn_exp2f(p1[r]);
  float ps = 0; for (int r = 0; r < 16; ++r) ps += p0[r]; for (int r = 0; r < 16; ++r) ps += p1[r];
  { auto rr = __builtin_amdgcn_permlane32_swap(__float_as_uint(ps), __float_as_uint(ps), false, false);
    ps = __uint_as_float(rr[0]) + __uint_as_float(rr[1]); }
  l_reg = l_reg * alpha + ps;
#define PK4(P, BASE, OUT) do { unsigned a0 = cvtpk(P[BASE + 0], P[BASE + 1]), a1 = cvtpk(P[BASE + 2], P[BASE + 3]);   \
    unsigned b0 = cvtpk(P[BASE + 4], P[BASE + 5]), b1 = cvtpk(P[BASE + 6], P[BASE + 7]);                              \
    auto r0 = __builtin_amdgcn_permlane32_swap(a0, b0, false, false); auto r1 = __builtin_amdgcn_permlane32_swap(a1, b1, false, false); \
    u32x4 w = {r0[0], r1[0], r0[1], r1[1]}; OUT = *reinterpret_cast<bf16x8*>(&w); } while (0)
  PK4(p0, 0, pa0); PK4(p0, 8, pa1); PK4(p1, 0, pa2); PK4(p1, 8, pa3);
#undef PK4
}
__device__ __forceinline__ void qkt(f32x16& p0, f32x16& p1, const bf16* Ks, const bf16x8* qr, int r32, int hi) {
  p0 = f32x16{}; p1 = f32x16{};
  for (int d0 = 0; d0 < 8; ++d0) { int cb = (d0 * 16 + hi * 8) * 2;
    bf16x8 b0 = *reinterpret_cast<const bf16x8*>((const char*)Ks + KSWZ(r32, cb));
    bf16x8 b1 = *reinterpret_cast<const bf16x8*>((const char*)Ks + KSWZ(32 + r32, cb));
    p0 = __builtin_amdgcn_mfma_f32_32x32x16_bf16(b0, qr[d0], p0, 0, 0, 0);
    p1 = __builtin_amdgcn_mfma_f32_32x32x16_bf16(b1, qr[d0], p1, 0, 0, 0); }
}
__device__ __forceinline__ int v_st(int k, int c) { const int kk = (k & ~0xC) | ((k & 4) << 1) | ((k & 8) >> 1); return ((kk >> 3) * 4 + (c >> 5)) * 512 + ((kk & 7) * 32 + (c & 31)) * 2; }
__device__ __forceinline__ int v_rd_base(int lane) { return ((lane & 3) << 3) | (((lane >> 2) & 3) << 6) | (((lane >> 4) & 1) << 5) | (((lane >> 5) & 1) << 8); }
constexpr int v_rd_off(int d0, int ks, int half) { return d0 * 512 + ks * 4096 + half * 2048; }
template <int OFF> __device__ __forceinline__ s16x4 tr_read(int vb) {
  s16x4 r; asm volatile("ds_read_b64_tr_b16 %0, %1 offset:%2" : "=&v"(r) : "v"(vb), "i"(OFF) : "memory"); return r;
}
template <int D0> __device__ __forceinline__ void pv_one(f32x16& od, int vb, bf16x8 pa0, bf16x8 pa1, bf16x8 pa2, bf16x8 pa3) {
  const s16x4 l0 = tr_read<v_rd_off(D0, 0, 0)>(vb), h0 = tr_read<v_rd_off(D0, 0, 1)>(vb), l1 = tr_read<v_rd_off(D0, 1, 0)>(vb), h1 = tr_read<v_rd_off(D0, 1, 1)>(vb);
  const s16x4 l2 = tr_read<v_rd_off(D0, 2, 0)>(vb), h2 = tr_read<v_rd_off(D0, 2, 1)>(vb), l3 = tr_read<v_rd_off(D0, 3, 0)>(vb), h3 = tr_read<v_rd_off(D0, 3, 1)>(vb);
  asm volatile("s_waitcnt lgkmcnt(0)" ::: "memory"); SBAR();
#define PK(L, H) (bf16x8){L[0], L[1], L[2], L[3], H[0], H[1], H[2], H[3]}
  od = __builtin_amdgcn_mfma_f32_32x32x16_bf16(pa0, PK(l0, h0), od, 0, 0, 0);
  od = __builtin_amdgcn_mfma_f32_32x32x16_bf16(pa1, PK(l1, h1), od, 0, 0, 0);
  od = __builtin_amdgcn_mfma_f32_32x32x16_bf16(pa2, PK(l2, h2), od, 0, 0, 0);
  od = __builtin_amdgcn_mfma_f32_32x32x16_bf16(pa3, PK(l3, h3), od, 0, 0, 0);
#undef PK
}
__device__ __forceinline__ void pv_d0(f32x16* o, int vb, bf16x8 pa0, bf16x8 pa1, bf16x8 pa2, bf16x8 pa3) {
  pv_one<0>(o[0], vb, pa0, pa1, pa2, pa3); pv_one<1>(o[1], vb, pa0, pa1, pa2, pa3); pv_one<2>(o[2], vb, pa0, pa1, pa2, pa3); pv_one<3>(o[3], vb, pa0, pa1, pa2, pa3);
}

template <typename TQ>
__device__ __forceinline__ void attn_dense_body(const TQ* __restrict__ Qb, const bf16* __restrict__ Kh, const bf16* __restrict__ Vh,
                                                bf16* __restrict__ Ob, int seq, char* lds) {
  using St = Stage<bf16>; using SQ = Stage<TQ>;
  int tid_ = threadIdx.x; asm volatile("" : "+v"(tid_)); const int tid = tid_, wid = tid >> 6, lane = tid & 63, r32 = lane & 31, hi = lane >> 5;
  bf16* V_lds = (bf16*)lds; bf16* K_lds = (bf16*)(lds + 2 * SHM_V);
  float* ws = (float*)(lds + 2 * SHM_V + 2 * SHM_K) + wid * 64; float* li_l = ws; float* al_l = ws + 32;
  float m_reg = -1e30f, l_reg = 0; f32x16 o[4] = {}; bf16x8 qr[8];
  const TQ* Qw = Qb + (long)(wid * QBLK + r32) * LDQ + hi * 8;
#pragma unroll
  for (int d0 = 0; d0 < 8; ++d0) qr[d0] = SQ::tobf(SQ::ld8(Qw + d0 * 16));
  const int sr = tid >> 4, sc = (tid & 15) * 8, vst0 = v_st(sr, sc), vst1 = v_st(32 + sr, sc);
  const int vb0 = (int)(uintptr_t)V_lds + v_rd_base(lane);
  struct { typename St::T vs0, vs1, ks0, ks1; } sr_[SDEPTH];
#define SLOAD(i, k0) do { sr_[i].vs0 = St::ld8(&Vh[(long)((k0) + sr) * LDK + sc]); sr_[i].vs1 = St::ld8(&Vh[(long)((k0) + 32 + sr) * LDK + sc]); \
    sr_[i].ks0 = St::ld8(&Kh[(long)((k0) + sr) * LDK + sc]); sr_[i].ks1 = St::ld8(&Kh[(long)((k0) + 32 + sr) * LDK + sc]); } while (0)
#define SWRITE(b, i) do { *(bf16x8*)((char*)V_lds + (b) * SHM_V + vst0) = St::tobf(sr_[i].vs0);          \
    *(bf16x8*)((char*)V_lds + (b) * SHM_V + vst1) = St::tobf(sr_[i].vs1); int kc = sc * 2;               \
    *(bf16x8*)((char*)K_lds + (b) * SHM_K + KSWZ(sr, kc)) = St::tobf(sr_[i].ks0);                       \
    *(bf16x8*)((char*)K_lds + (b) * SHM_K + KSWZ(32 + sr, kc)) = St::tobf(sr_[i].ks1); } while (0)
#define SWAIT() do { if constexpr (SDEPTH == 2) asm volatile("s_waitcnt vmcnt(4)" ::: "memory"); else asm volatile("s_waitcnt vmcnt(0)" ::: "memory"); } while (0)
#define RESC(a) do { if (__any((a) < 1.f)) { if (hi == 0) al_l[r32] = (a); asm volatile("s_waitcnt lgkmcnt(0)" ::: "memory"); \
    for (int d = 0; d < 4; ++d) for (int r = 0; r < 16; ++r) o[d][r] *= al_l[crow(r, hi)]; } } while (0)
  f32x16 pA0, pA1, pB0, pB1; float mnA, mnB, alA, alB; bf16x8 pa0, pa1, pa2, pa3; const int NT = seq / KVBLK;
  constexpr int SE = 0, SO = SDEPTH - 1;
  SLOAD(SE, 0); asm volatile("s_waitcnt vmcnt(0)" ::: "memory"); SWRITE(0, SE); __syncthreads();
  qkt(pA0, pA1, K_lds, qr, r32, hi); partialSM(pA0, pA1, m_reg, mnA, alA);
  SLOAD(SO, KVBLK); if constexpr (SDEPTH == 2) { if (2 < NT) SLOAD(SE, 2 * KVBLK); }
  SWAIT(); SWRITE(1, SO); __syncthreads();
  for (int j = 1; j + 1 < NT; j += 2) {
    SBAR(); qkt(pB0, pB1, (bf16*)((char*)K_lds + SHM_K), qr, r32, hi);
    finishSM(pA0, pA1, alA, l_reg, pa0, pa1, pa2, pa3); SBAR();
    SLOAD(SO, (j + SDEPTH) * KVBLK); SBAR();
    pv_d0(o, vb0, pa0, pa1, pa2, pa3); partialSM(pB0, pB1, m_reg, mnB, alB);
    __syncthreads(); SWAIT(); SWRITE(0, SE);
    RESC(alB); __syncthreads();
    SBAR(); qkt(pA0, pA1, K_lds, qr, r32, hi);
    finishSM(pB0, pB1, alB, l_reg, pa0, pa1, pa2, pa3); SBAR();
    if (SDEPTH == 1 || j + 3 < NT) SLOAD(SE, (j + 1 + SDEPTH) * KVBLK); SBAR();
    pv_d0(o, vb0 + (int)SHM_V, pa0, pa1, pa2, pa3); partialSM(pA0, pA1, m_reg, mnA, alA);
    __syncthreads(); SWAIT(); SWRITE(1, SO);
    RESC(alA); __syncthreads();
  }
  SBAR(); qkt(pB0, pB1, (bf16*)((char*)K_lds + SHM_K), qr, r32, hi);
  finishSM(pA0, pA1, alA, l_reg, pa0, pa1, pa2, pa3); SBAR();
  pv_d0(o, vb0, pa0, pa1, pa2, pa3); partialSM(pB0, pB1, m_reg, mnB, alB);
  __syncthreads(); RESC(alB);
  finishSM(pB0, pB1, alB, l_reg, pa0, pa1, pa2, pa3); SBAR();
  pv_d0(o, vb0 + (int)SHM_V, pa0, pa1, pa2, pa3);
  if (hi == 0) li_l[r32] = l_reg; asm volatile("s_waitcnt lgkmcnt(0)" ::: "memory");
  float rli[16];
#pragma unroll
  for (int r = 0; r < 16; ++r) rli[r] = __builtin_amdgcn_rcpf(li_l[crow(r, hi)]);
  bf16* Ow = Ob + (long)(wid * QBLK) * LDO;
#pragma unroll
  for (int r = 0; r < 16; ++r) { int orow = crow(r, hi);
#pragma unroll
    for (int d0 = 0; d0 < 4; ++d0) Ow[(long)orow * LDO + d0 * 32 + r32] = __float2bfloat16(o[d0][r] * rli[r]); }
#undef SLOAD
#undef SWRITE
#undef SWAIT
#undef RESC
}

#undef KSWZ
}

#define LAS __attribute__((address_space(3)))
typedef unsigned short bf16_t;
typedef float f32x2 __attribute__((ext_vector_type(2)));
typedef float f32x4 __attribute__((ext_vector_type(4)));
typedef unsigned u32x4 __attribute__((ext_vector_type(4)));
typedef unsigned u32x2 __attribute__((ext_vector_type(2)));

struct Params { const float* in[24]; float* out; unsigned char* ws; };
typedef const __attribute__((address_space(4))) Params* ParamsPtr;
#if defined(__HIP_DEVICE_COMPILE__)
__device__ __forceinline__ Params get_params() { ParamsPtr q = (ParamsPtr)__builtin_amdgcn_kernarg_segment_ptr(); asm volatile("" : "+s"(q)); return *q; }
#else
__device__ __forceinline__ Params get_params() { return Params{}; }
#endif
__device__ __forceinline__ int lv(int x) { asm volatile("" : "+v"(x)); return x; }
__device__ __forceinline__ int ls(int x) { asm volatile("" : "+s"(x)); return x; }
#define TID() lv((int)threadIdx.x)
#define BID() ls((int)blockIdx.x)
#define NBLK() ls((int)gridDim.x)

constexpr size_t SZ_WIN = (size_t)NIN * DM * 2, SZ_WHY = (size_t)DM * HYW * 2, SZ_WAT = (size_t)DM * QW * 2, SZ_WO = (size_t)DM * DM * 2, SZ_WUP = (size_t)DFF * DM * 2, SZ_WDN = (size_t)DM * DFF * 2;
constexpr size_t WS_WIN = 0, WS_WHY = WS_WIN + SZ_WIN, WS_WAT = WS_WHY + SZ_WHY, WS_WO = WS_WAT + SZ_WAT, WS_WUP = WS_WO + SZ_WO, WS_WDN = WS_WUP + SZ_WUP;
constexpr size_t WS_HB = WS_WDN + SZ_WDN;

constexpr size_t WS_X = WS_HB + (size_t)NTOK * DM * 2;
constexpr size_t WS_PH = WS_X, WS_QKV = WS_PH + (size_t)NTOK * 3072 * 2, WS_G = WS_QKV + (size_t)NTOK * 1536 * 2;
constexpr size_t WS_FF = WS_X, WS_YHY = WS_PH, WS_YAT = WS_PH + (size_t)NTOK * HYW * 2, WS_YT = WS_YAT + (size_t)NTOK * QW * 2, WS_MRG = WS_YT;
constexpr size_t WS_R = WS_X + (size_t)NTOK * NIN * 2;
constexpr size_t WS_Z = WS_R, WS_X0T = WS_R + (size_t)HYW * NTOK * 4, WS_RB = WS_R;
constexpr size_t WS_HDN = WS_X0T + (size_t)HYW * NTOK * 2;
constexpr size_t WS_ROPE = WS_HDN + (size_t)DEPTH * SEQL * FHID * 4;
constexpr size_t WS_BAR = WS_ROPE + 128 * 32 * 8;
constexpr size_t WS_STATS = WS_BAR + 3456 * 4;
constexpr size_t WS_PUIN = WS_STATS + (size_t)3 * NTOK * 2 * 4;
constexpr size_t WS_PVIN = WS_PUIN + (size_t)NIN * 4, WS_PUUP = WS_PVIN + (size_t)NIN * 4, WS_PVUP = WS_PUUP + (size_t)DFF * 4;
constexpr size_t WS_END = WS_PVUP + (size_t)DFF * 4;

constexpr int FFTN = 16384, FFT_LDS = (FFTN + FFTN / 16) * 8;
constexpr int XST_OFF = FFT_LDS + 1024 + (1024 + 128 + 16) * 8;
constexpr int LDS_BYTES = XST_OFF + 16;

__device__ __forceinline__ float bf_lo(unsigned w) { return __uint_as_float(w << 16); }
__device__ __forceinline__ float bf_hi(unsigned w) { return __uint_as_float(w & 0xffff0000u); }
__device__ __forceinline__ unsigned pk_bf16(float lo, float hi) { return pg8::cvt_pk_bf16(lo, hi); }

struct LnFold { const float* stats; const float* g; const float* b; const float* pu; const float* pv; };
__device__ __forceinline__ void ln_row_stats(const float* stats, size_t r, float& mean, float& rstd) {
    const f32x2 sq = *(const f32x2*)(stats + 2 * r); mean = sq.x * (1.0f / DM); rstd = rsqrtf(fmaxf(sq.y * (1.0f / DM) - mean * mean, 0.f) + LN_EPS);
}
#define PIN16F(A, B) asm volatile("" : "+v"(A[B]), "+v"(A[B + 1]), "+v"(A[B + 2]), "+v"(A[B + 3]), "+v"(A[B + 4]), "+v"(A[B + 5]), "+v"(A[B + 6]), "+v"(A[B + 7]), \
    "+v"(A[B + 8]), "+v"(A[B + 9]), "+v"(A[B + 10]), "+v"(A[B + 11]), "+v"(A[B + 12]), "+v"(A[B + 13]), "+v"(A[B + 14]), "+v"(A[B + 15]))
__device__ __forceinline__ void pin4(u32x4& a, u32x4& b, u32x4& c, u32x4& d) { asm volatile("" : "+v"(a), "+v"(b), "+v"(c), "+v"(d)); }
__device__ __forceinline__ void pin4f(f32x4& a, f32x4& b, f32x4& c, f32x4& d) { asm volatile("" : "+v"(a), "+v"(b), "+v"(c), "+v"(d)); }
__device__ __forceinline__ void pin8(u32x4& a, u32x4& b, u32x4& c, u32x4& d, u32x4& e, u32x4& f, u32x4& g, u32x4& h) { asm volatile("" : "+v"(a), "+v"(b), "+v"(c), "+v"(d), "+v"(e), "+v"(f), "+v"(g), "+v"(h)); }
__device__ __forceinline__ void pin8f(f32x4& a, f32x4& b, f32x4& c, f32x4& d, f32x4& e, f32x4& f, f32x4& g, f32x4& h) { asm volatile("" : "+v"(a), "+v"(b), "+v"(c), "+v"(d), "+v"(e), "+v"(f), "+v"(g), "+v"(h)); }
template <int MODE> struct EpiX {
    static constexpr bool PERM = true, AFTER_DRAIN = false;
    bf16_t* O; int ldc; bf16_t* O2; bf16_t* O3; const bf16_t* G; int gofs; LnFold f; float* stats_out;
    __device__ __forceinline__ void mid(pg8::f32x4 (&acc)[2][2][4][2], const pg8::Unit& u, int wr, int wc, int fr, int fq) const {
        const int row0 = lv(u.pm * 256 + wr * 64 + fr), col0 = u.pn * 256 + wc * 32 + 8 * fq;
#pragma unroll
        for (int ai = 0; ai < 2; ++ai)
#pragma unroll
            for (int mp = 0; mp < 2; ++mp) {
                u32x4 gh[2][2], ga[2][2];
#pragma unroll
                for (int mm = 0; mm < 2; ++mm)
#pragma unroll
                    for (int bj = 0; bj < 2; ++bj) { const size_t r = (size_t)(row0 + ai * 128 + (mp * 2 + mm) * 16);
                        gh[mm][bj] = *(const u32x4*)(G + r * 4096 + col0 + bj * 128); ga[mm][bj] = *(const u32x4*)(G + r * 4096 + DM + col0 + bj * 128); }
                pin8(gh[0][0], gh[0][1], gh[1][0], gh[1][1], ga[0][0], ga[0][1], ga[1][0], ga[1][1]);
#pragma unroll
                for (int mm = 0; mm < 2; ++mm)
#pragma unroll
                    for (int bj = 0; bj < 2; ++bj) { const int m = mp * 2 + mm; const u32x4 h = gh[mm][bj], a = ga[mm][bj];
                        acc[ai][bj][m][0][0] *= bf_lo(h.x) * __builtin_amdgcn_rcpf(bf_lo(a.x)); acc[ai][bj][m][0][1] *= bf_hi(h.x) * __builtin_amdgcn_rcpf(bf_hi(a.x));
                        acc[ai][bj][m][0][2] *= bf_lo(h.y) * __builtin_amdgcn_rcpf(bf_lo(a.y)); acc[ai][bj][m][0][3] *= bf_hi(h.y) * __builtin_amdgcn_rcpf(bf_hi(a.y));
                        acc[ai][bj][m][1][0] *= bf_lo(h.z) * __builtin_amdgcn_rcpf(bf_lo(a.z)); acc[ai][bj][m][1][1] *= bf_hi(h.z) * __builtin_amdgcn_rcpf(bf_hi(a.z));
                        acc[ai][bj][m][1][2] *= bf_lo(h.w) * __builtin_amdgcn_rcpf(bf_lo(a.w)); acc[ai][bj][m][1][3] *= bf_hi(h.w) * __builtin_amdgcn_rcpf(bf_hi(a.w)); }
            }
    }
    __device__ __forceinline__ void operator()(const pg8::f32x4 (&acc)[2][2][4][2], const pg8::Unit& u, int wr, int wc, int fr, int fq) const {
        const int row0 = lv(u.pm * 256 + wr * 64 + fr); int colt = u.pn * 256; bf16_t* base = O; int ld = ldc; bool sig = false;
        const int colg = u.pn * 256 + wc * 32 + 8 * fq;
        if (MODE == 0) { if (u.pn >= 18) { base = O3; ld = 4096; colt -= 4608; sig = true; } else if (u.pn >= 12) { base = O2; ld = 1536; colt -= 3072; } }
        const int col0 = colt + wc * 32 + 8 * fq;
        constexpr bool FOLD_A = (MODE == 0 || MODE == 4), RES = (MODE == 5), GATE = (MODE == 1 || MODE == 2 || MODE == 6);
        const bool fold = (FOLD_A || RES) && f.stats != nullptr;
        float cu[2][8], cv[2][8]; f32x2 st[2][4];
        if (FOLD_A || RES) {
#pragma unroll
            for (int bj = 0; bj < 2; ++bj)
#pragma unroll
                for (int e = 0; e < 8; ++e) { cu[bj][e] = RES ? 1.f : 0.f; cv[bj][e] = 0.f; }
            if (FOLD_A) {
#pragma unroll
                for (int ai = 0; ai < 2; ++ai)
#pragma unroll
                    for (int m = 0; m < 4; ++m) st[ai][m] = (f32x2){0.f, 0.f}; }
            if (fold) {
                const float* pa = FOLD_A ? f.pu : f.g; const float* pb = FOLD_A ? f.pv : f.b;
                f32x4 t[2][4];
#pragma unroll
                for (int bj = 0; bj < 2; ++bj) { const int c = colg + bj * 128; t[bj][0] = *(const f32x4*)(pa + c); t[bj][1] = *(const f32x4*)(pa + c + 4); t[bj][2] = *(const f32x4*)(pb + c); t[bj][3] = *(const f32x4*)(pb + c + 4); }
                if (FOLD_A) {
#pragma unroll
                    for (int ai = 0; ai < 2; ++ai)
#pragma unroll
                        for (int m = 0; m < 4; ++m) st[ai][m] = *(const f32x2*)(f.stats + 2 * (size_t)(row0 + ai * 128 + m * 16)); }
                if (FOLD_A) asm volatile("" : "+v"(t[0][0]), "+v"(t[0][1]), "+v"(t[0][2]), "+v"(t[0][3]), "+v"(t[1][0]), "+v"(t[1][1]), "+v"(t[1][2]), "+v"(t[1][3]),
                                  "+v"(st[0][0]), "+v"(st[0][1]), "+v"(st[0][2]), "+v"(st[0][3]), "+v"(st[1][0]), "+v"(st[1][1]), "+v"(st[1][2]), "+v"(st[1][3]));
                else pin8f(t[0][0], t[0][1], t[0][2], t[0][3], t[1][0], t[1][1], t[1][2], t[1][3]);
#pragma unroll
                for (int bj = 0; bj < 2; ++bj)
#pragma unroll
                    for (int e = 0; e < 4; ++e) { cu[bj][e] = t[bj][0][e]; cu[bj][4 + e] = t[bj][1][e]; cv[bj][e] = t[bj][2][e]; cv[bj][4 + e] = t[bj][3][e]; }
            }
        }
#pragma unroll
        for (int ai = 0; ai < 2; ++ai) {
            u32x4 xw[4][2];
            if (RES || GATE) {
#pragma unroll
                for (int m = 0; m < 4; ++m)
#pragma unroll
                    for (int bj = 0; bj < 2; ++bj) { const size_t r = (size_t)(row0 + ai * 128 + m * 16);
                        xw[m][bj] = RES ? *(const u32x4*)(G + r * DM + col0 + bj * 128) : *(const u32x4*)(G + r * 4096 + gofs + col0 + bj * 128); }
            }
            f32x2 sr[4] = {{0.f, 0.f}, {0.f, 0.f}, {0.f, 0.f}, {0.f, 0.f}};
            if (RES) { if (fold) {
#pragma unroll
                for (int m = 0; m < 4; ++m) sr[m] = *(const f32x2*)(f.stats + 2 * (size_t)(row0 + ai * 128 + m * 16));
                asm volatile("" : "+v"(sr[0]), "+v"(sr[1]), "+v"(sr[2]), "+v"(sr[3])); } }
            if (RES || GATE) pin8(xw[0][0], xw[0][1], xw[1][0], xw[1][1], xw[2][0], xw[2][1], xw[3][0], xw[3][1]);
#pragma unroll
            for (int m = 0; m < 4; ++m) {
                const size_t r = (size_t)(row0 + ai * 128 + m * 16);
                bf16_t* rowp = base + r * ld + col0;
                float mean = 0.f, rstd = 1.f;
                if ((FOLD_A || RES) && fold) { const f32x2 sq = RES ? sr[m] : st[ai][m]; mean = sq.x * (1.0f / DM); rstd = rsqrtf(fmaxf(sq.y * (1.0f / DM) - mean * mean, 0.f) + LN_EPS); }
                float ssum = 0.f, ssq = 0.f;
#pragma unroll
                for (int bj = 0; bj < 2; ++bj) {
                    float v[8] = {acc[ai][bj][m][0][0], acc[ai][bj][m][0][1], acc[ai][bj][m][0][2], acc[ai][bj][m][0][3], acc[ai][bj][m][1][0], acc[ai][bj][m][1][1], acc[ai][bj][m][1][2], acc[ai][bj][m][1][3]};
                    if (FOLD_A) { if (fold) {
#pragma unroll
                        for (int e = 0; e < 8; ++e) v[e] = rstd * (v[e] - mean * cu[bj][e]) + cv[bj][e]; } }
                    if (MODE == 0) { if (sig) {
#pragma unroll
                        for (int e = 0; e < 8; ++e) v[e] = __builtin_amdgcn_rcpf(1.0f + __expf(-v[e])); } }
                    if (GATE) { const u32x4 gw = xw[m][bj];
                        v[0] *= bf_lo(gw.x); v[1] *= bf_hi(gw.x); v[2] *= bf_lo(gw.y); v[3] *= bf_hi(gw.y); v[4] *= bf_lo(gw.z); v[5] *= bf_hi(gw.z); v[6] *= bf_lo(gw.w); v[7] *= bf_hi(gw.w); }
                    if (MODE == 2) {
                        const u32x4 ow = *(const u32x4*)(rowp + bj * 128);
                        v[0] += bf_lo(ow.x); v[1] += bf_hi(ow.x); v[2] += bf_lo(ow.y); v[3] += bf_hi(ow.y); v[4] += bf_lo(ow.z); v[5] += bf_hi(ow.z); v[6] += bf_lo(ow.w); v[7] += bf_hi(ow.w); }
                    if (RES) { const u32x4 hw = xw[m][bj];
                        const float h[8] = {bf_lo(hw.x), bf_hi(hw.x), bf_lo(hw.y), bf_hi(hw.y), bf_lo(hw.z), bf_hi(hw.z), bf_lo(hw.w), bf_hi(hw.w)};
#pragma unroll
                        for (int e = 0; e < 8; ++e) { const float hh = fold ? ((h[e] - mean) * rstd * cu[bj][e] + cv[bj][e]) : h[e]; v[e] += ALPHA_F * hh; ssum += v[e]; ssq += v[e] * v[e]; } }
                    if (MODE == 4) {
#pragma unroll
                        for (int e = 0; e < 8; ++e) { const float a = fmaxf(v[e], 0.f); v[e] = a * a; } }
                    u32x4 w; w.x = pk_bf16(v[0], v[1]); w.y = pk_bf16(v[2], v[3]); w.z = pk_bf16(v[4], v[5]); w.w = pk_bf16(v[6], v[7]);
                    *(u32x4*)(rowp + bj * 128) = w; }
                if (RES) { if (stats_out != nullptr) {
                    ssum += __shfl_xor(ssum, 16); ssum += __shfl_xor(ssum, 32); ssq += __shfl_xor(ssq, 16); ssq += __shfl_xor(ssq, 32);
                    if (fq == 0) { atomicAdd(stats_out + 2 * r, ssum); atomicAdd(stats_out + 2 * r + 1, ssq); } } }
            }
        }
    }
};

template <int MODE>
__device__ __forceinline__ void run_gemm(unsigned char* lds, const bf16_t* A, const bf16_t* Bt, int N, int K, const EpiX<MODE>& E, const bf16_t* A2 = nullptr, const bf16_t* Bt2 = nullptr) {
    pg8::Gemm g{A, Bt, NTOK, N, K, A2, Bt2}; pg8::StaticOrder S; S.init(NTOK, N, NBLK(), BID(), N >= 8192 ? WGM_WIDE : WGM_NARROW);
    pg8::gemm_phase<EpiX<MODE>, pg8::StaticOrder, MODE == 6>((PG8_LAS unsigned char*)lds, g, S, E);
}

struct CvtJob { const float* src; bf16_t* dst; int K, N, tk, tn; };
__device__ __forceinline__ CvtJob cvt_plain_job(const Params& p, int layer, int id) {
    CvtJob j; int loc; unsigned char* ws = p.ws;
    if (id < 512)        { loc = id;         j.K = HYW; j.N = DM;  j.src = p.in[15] + (size_t)layer * HYW * DM;  j.dst = (bf16_t*)(ws + WS_WHY); }
    else if (id < 1024)  { loc = id - 512;   j.K = QW;  j.N = DM;  j.src = p.in[16] + (size_t)layer * QW * DM;   j.dst = (bf16_t*)(ws + WS_WAT); }
    else if (id < 2048)  { loc = id - 1024;  j.K = DM;  j.N = DM;  j.src = p.in[17] + (size_t)layer * DM * DM;   j.dst = (bf16_t*)(ws + WS_WO); }
    else                 { loc = id - 2048;  j.K = DFF; j.N = DM;  j.src = p.in[21] + (size_t)layer * DFF * DM;  j.dst = (bf16_t*)(ws + WS_WDN); }
    const int ntn = j.N >> 6; j.tk = loc / ntn; j.tn = loc - j.tk * ntn; return j;
}
__device__ __forceinline__ void convert_weights_phase(int layer, unsigned char* lds) {
    const Params p = get_params(); const int bid = BID(), nblk = NBLK();
    LAS float* tile = (LAS float*)lds; const int tid = TID();
    constexpr int TS = 64 * 65, NS_IN = 136, NS = 264, NPLAIN = 768;
    const bool bal = (nblk == 256);
    const int nstrip_mine = bal ? (bid < 8 ? 2 : 1) : (NS - bid + nblk - 1) / nblk;
    const int plain0 = bal ? bid - 8 : bid, pstep = bal ? 248 : nblk;
    const int nplain_mine = (bal && bid < 8) ? 0 : (plain0 < NPLAIN ? (NPLAIN - plain0 + pstep - 1) / pstep : 0);
    const int nsteps = nstrip_mine * 4 + nplain_mine;
    float pu = 0.f, pv = 0.f;
    for (int st = 0; st < nsteps; ++st) {
        const bool strip = st < nstrip_mine * 4;
        const int sidx = bal ? bid + 256 * (st >> 2) : bid + nblk * (st >> 2), sq = st & 3;
        const bool is_in = sidx < NS_IN; const int stn = is_in ? sidx : sidx - NS_IN;
        CvtJob sj; sj.K = DM; sj.N = is_in ? NIN : DFF; sj.tn = stn; sj.tk = sq * 8;
        sj.src = is_in ? p.in[3] + (size_t)layer * DM * NIN : p.in[20] + (size_t)layer * DM * DFF; sj.dst = (bf16_t*)(p.ws + (is_in ? WS_WIN : WS_WUP));
        const float* fg = is_in ? (layer > 0 ? p.in[22] + (size_t)(layer - 1) * DM : nullptr) : p.in[18] + (size_t)layer * DM;
        const float* fb = is_in ? (layer > 0 ? p.in[23] + (size_t)(layer - 1) * DM : nullptr) : p.in[19] + (size_t)layer * DM;
        const int pbase = (plain0 + pstep * (st - nstrip_mine * 4)) * 8;
        f32x4 a[8], b[8];
#pragma unroll
        for (int q = 0; q < 8; ++q) { CvtJob j = sj; if (strip) j.tk = sj.tk + q; else j = cvt_plain_job(p, layer, pbase + q);
            const int kk = tid >> 3, n8 = (tid & 7) * 8; const float* s = j.src + (size_t)(j.tk * 64 + kk) * j.N + j.tn * 64 + n8;
            a[q] = __builtin_nontemporal_load((const f32x4*)s); b[q] = __builtin_nontemporal_load((const f32x4*)(s + 4)); }
        LAS float* gbs = tile + 8 * TS;
        if (strip && sq == 0 && fg != nullptr) { const f32x4 gq = *(const f32x4*)(fg + tid * 4), bq = *(const f32x4*)(fb + tid * 4); *(LAS f32x4*)(gbs + tid * 4) = gq; *(LAS f32x4*)(gbs + DM + tid * 4) = bq; }
#pragma unroll
        for (int q = 0; q < 8; ++q) { const int kk = tid >> 3, n8 = (tid & 7) * 8;
            LAS float* d = tile + q * TS + kk * 65 + n8; d[0] = a[q][0]; d[1] = a[q][1]; d[2] = a[q][2]; d[3] = a[q][3]; d[4] = b[q][0]; d[5] = b[q][1]; d[6] = b[q][2]; d[7] = b[q][3]; }
        __syncthreads();
        if (strip && sq == 0) { pu = 0.f; pv = 0.f; }
#pragma unroll
        for (int q = 0; q < 8; ++q) { CvtJob j = sj; if (strip) j.tk = sj.tk + q; else j = cvt_plain_job(p, layer, pbase + q);
            const int n = tid >> 3, k8 = (tid & 7) * 8; float v[8];
#pragma unroll
            for (int e = 0; e < 8; ++e) v[e] = tile[q * TS + (k8 + e) * 65 + n];
            if (strip) { const int k0 = j.tk * 64 + k8;
                if (fg != nullptr) { const f32x4 g0 = *(const LAS f32x4*)(gbs + k0), g1 = *(const LAS f32x4*)(gbs + k0 + 4), b0 = *(const LAS f32x4*)(gbs + DM + k0), b1 = *(const LAS f32x4*)(gbs + DM + k0 + 4);
#pragma unroll
                    for (int e = 0; e < 4; ++e) { pv += b0[e] * v[e] + b1[e] * v[4 + e]; v[e] *= g0[e]; v[4 + e] *= g1[e]; } } }
            u32x4 w; w.x = pk_bf16(v[0], v[1]); w.y = pk_bf16(v[2], v[3]); w.z = pk_bf16(v[4], v[5]); w.w = pk_bf16(v[6], v[7]);
            if (strip) pu += ((bf_lo(w.x) + bf_hi(w.x)) + (bf_lo(w.y) + bf_hi(w.y))) + ((bf_lo(w.z) + bf_hi(w.z)) + (bf_lo(w.w) + bf_hi(w.w)));
            *(u32x4*)(j.dst + (size_t)(j.tn * 64 + n) * j.K + j.tk * 64 + k8) = w; }
        if (strip && sq == 3) {
            float ru = pu, rv = pv;
            ru += __shfl_xor(ru, 1); ru += __shfl_xor(ru, 2); ru += __shfl_xor(ru, 4); rv += __shfl_xor(rv, 1); rv += __shfl_xor(rv, 2); rv += __shfl_xor(rv, 4);
            if ((tid & 7) == 0) { const int n = stn * 64 + (tid >> 3); ((float*)(p.ws + (is_in ? WS_PUIN : WS_PUUP)))[n] = ru; ((float*)(p.ws + (is_in ? WS_PVIN : WS_PVUP)))[n] = rv; } }
        __syncthreads();
    }
}

template <int MODE>
__device__ __forceinline__ void ln_row_load(const Params& p, const bf16_t* rsrc, int row, int lane, float (&v)[32]) {
    if (MODE == 0) {
#pragma unroll
        for (int k = 0; k < 8; ++k) { const f32x4 x = *(const f32x4*)(p.in[0] + (size_t)row * DM + (k * 64 + lane) * 4); v[4 * k] = x[0]; v[4 * k + 1] = x[1]; v[4 * k + 2] = x[2]; v[4 * k + 3] = x[3]; }
    } else {
#pragma unroll
        for (int k = 0; k < 4; ++k) { const u32x4 w = *(const u32x4*)(rsrc + (size_t)row * DM + (k * 64 + lane) * 8);
            v[8 * k] = bf_lo(w.x); v[8 * k + 1] = bf_hi(w.x); v[8 * k + 2] = bf_lo(w.y); v[8 * k + 3] = bf_hi(w.y); v[8 * k + 4] = bf_lo(w.z); v[8 * k + 5] = bf_hi(w.z); v[8 * k + 6] = bf_lo(w.w); v[8 * k + 7] = bf_hi(w.w); }
    }
}
template <int MODE>
__device__ __forceinline__ void ln_load_gb(const float* g, const float* b, int lane, float (&gg)[32], float (&bb)[32]) {
    f32x4 tg[8], tb[8];
#pragma unroll
    for (int k = 0; k < 8; ++k) { const int c = MODE == 0 ? (k * 64 + lane) * 4 : ((k >> 1) * 64 + lane) * 8 + (k & 1) * 4; tg[k] = *(const f32x4*)(g + c); tb[k] = *(const f32x4*)(b + c); }
    pin8f(tg[0], tg[1], tg[2], tg[3], tg[4], tg[5], tg[6], tg[7]); pin8f(tb[0], tb[1], tb[2], tb[3], tb[4], tb[5], tb[6], tb[7]);
#pragma unroll
    for (int k = 0; k < 8; ++k)
#pragma unroll
        for (int e = 0; e < 4; ++e) { gg[4 * k + e] = tg[k][e]; bb[4 * k + e] = tb[k][e]; }
}
template <int MODE>
__device__ __forceinline__ void ln_row_finish(const Params& p, const float (&gg)[32], const float (&bb)[32], bf16_t* hb, int row, int lane, const float (&v)[32]) {
    float sum = 0.f;
#pragma unroll
    for (int e = 0; e < 32; ++e) sum += v[e];
#pragma unroll
    for (int o = 32; o > 0; o >>= 1) sum += __shfl_xor(sum, o);
    const float mean = sum * (1.0f / DM);
    float q = 0.f;
#pragma unroll
    for (int e = 0; e < 32; ++e) { const float d = v[e] - mean; q += d * d; }
#pragma unroll
    for (int o = 32; o > 0; o >>= 1) q += __shfl_xor(q, o);
    const float rstd = rsqrtf(q * (1.0f / DM) + LN_EPS);
    float o[32];
#pragma unroll
    for (int e = 0; e < 32; ++e) o[e] = (v[e] - mean) * rstd * gg[e] + bb[e];
    if (MODE == 0) {
#pragma unroll
        for (int k = 0; k < 8; ++k) { const int c = (k * 64 + lane) * 4; u32x2 w; w.x = pk_bf16(o[4 * k], o[4 * k + 1]); w.y = pk_bf16(o[4 * k + 2], o[4 * k + 3]); *(u32x2*)(hb + (size_t)row * DM + c) = w; }
    } else {
#pragma unroll
        for (int k = 0; k < 4; ++k) { const int c = (k * 64 + lane) * 8;
            if (MODE == 1) { u32x4 w; w.x = pk_bf16(o[8 * k], o[8 * k + 1]); w.y = pk_bf16(o[8 * k + 2], o[8 * k + 3]); w.z = pk_bf16(o[8 * k + 4], o[8 * k + 5]); w.w = pk_bf16(o[8 * k + 6], o[8 * k + 7]); *(u32x4*)(hb + (size_t)row * DM + c) = w; }
            else { *(f32x4*)(p.out + (size_t)row * DM + c) = (f32x4){o[8 * k], o[8 * k + 1], o[8 * k + 2], o[8 * k + 3]}; *(f32x4*)(p.out + (size_t)row * DM + c + 4) = (f32x4){o[8 * k + 4], o[8 * k + 5], o[8 * k + 6], o[8 * k + 7]}; } }
    }
}
template <int MODE>
__device__ __forceinline__ void ln_phase(int gi, int bi, int layer) {
    const Params p = get_params(); const int bid = BID(), nblk = NBLK();
    const float* g = p.in[gi] + layer * DM; const float* b = p.in[bi] + layer * DM; bf16_t* hb = (bf16_t*)(p.ws + WS_HB);
    const bf16_t* rsrc = (const bf16_t*)(p.ws + WS_HB);
    const int tid = TID(), wid = tid >> 6, lane = tid & 63; const int rstride = nblk * 8;
    float gg[32], bb[32]; ln_load_gb<MODE>(g, b, lane, gg, bb);
    for (int row = bid * 8 + wid; row < NTOK; row += 2 * rstride) {
        float v0[32], v1[32]; const int row1 = row + rstride;
        ln_row_load<MODE>(p, rsrc, row, lane, v0);
        if (row1 < NTOK) ln_row_load<MODE>(p, rsrc, row1, lane, v1);
        ln_row_finish<MODE>(p, gg, bb, hb, row, lane, v0);
        if (row1 < NTOK) ln_row_finish<MODE>(p, gg, bb, hb, row1, lane, v1);
    }
}

__device__ __forceinline__ void hdn_phase(unsigned char* lds) {
    const Params p = get_params(); const int bid = BID(), nblk = NBLK();
    LAS float* feats = (LAS float*)lds;
    LAS float* h1 = feats + 64 * 33;
    const int tid = TID(); float* HDN = (float*)(p.ws + WS_HDN);
    { f32x2* TAB = (f32x2*)(p.ws + WS_ROPE);
      for (int i = bid * NTHR + tid; i < 128 * 32; i += nblk * NTHR) { const int pos = i >> 5, ii = i & 31;
          const float inv = exp2f(-(float)ii * (13.287712379549449f / 32.0f)); float sn, cs; sincosf((float)pos * inv, &sn, &cs); TAB[i] = (f32x2){cs, sn}; } }
    for (int it = bid; it < DEPTH * (SEQL / 64); it += nblk) {
        const int layer = it / (SEQL / 64), t0 = (it - layer * (SEQL / 64)) * 64;
        const float* w1 = p.in[6] + layer * FEMB * FHID; const float* b1 = p.in[7] + layer * FHID;
        const float* w2 = p.in[8] + layer * FHID * FHID; const float* b2 = p.in[9] + layer * FHID; const float* fr = p.in[11] + layer * FHID;
        __syncthreads();
#pragma unroll
        for (int q = 0; q < 2; ++q) { const int idx = q * NTHR + tid, tt = idx >> 4, bnd = idx & 15, pos = t0 + tt;
            const float wv = 6.283185307179586f * (float)pos / (float)SEQL; const float fb = 1e-4f + (float)bnd * ((15.0f - 1e-4f) / 15.0f);
            float sn, cs; sincosf(wv * fb, &sn, &cs); feats[tt * 33 + 1 + bnd] = cs; feats[tt * 33 + 17 + bnd] = -sn;
            if (bnd == 0) feats[tt * 33] = (float)pos / (float)(SEQL - 1); }
        __syncthreads();
        const int tt = tid >> 3, j8 = (tid & 7) * 8;
        { f32x4 a0 = *(const f32x4*)(b1 + j8), a1 = *(const f32x4*)(b1 + j8 + 4);
#pragma unroll 3
          for (int i = 0; i < FEMB; ++i) { const float f = feats[tt * 33 + i]; a0 += f * *(const f32x4*)(w1 + i * FHID + j8); a1 += f * *(const f32x4*)(w1 + i * FHID + j8 + 4); }
          const f32x4 f0 = *(const f32x4*)(fr + j8), f1 = *(const f32x4*)(fr + j8 + 4);
#pragma unroll
          for (int e = 0; e < 4; ++e) { h1[tt * 65 + j8 + e] = sinf(f0[e] * a0[e]); h1[tt * 65 + j8 + 4 + e] = sinf(f1[e] * a1[e]); } }
        __syncthreads();
        { f32x4 a0 = *(const f32x4*)(b2 + j8), a1 = *(const f32x4*)(b2 + j8 + 4);
#pragma unroll 4
          for (int i = 0; i < FHID; ++i) { const float f = h1[tt * 65 + i]; a0 += f * *(const f32x4*)(w2 + i * FHID + j8); a1 += f * *(const f32x4*)(w2 + i * FHID + j8 + 4); }
          const f32x4 f0 = *(const f32x4*)(fr + j8), f1 = *(const f32x4*)(fr + j8 + 4);
          f32x4 o0, o1;
#pragma unroll
          for (int e = 0; e < 4; ++e) { o0[e] = sinf(f0[e] * a0[e]); o1[e] = sinf(f1[e] * a1[e]); }
          float* dst = HDN + ((size_t)layer * SEQL + t0 + tt) * FHID + j8; *(f32x4*)dst = o0; *(f32x4*)(dst + 4) = o1; }
    }
}

__device__ __forceinline__ void hyena_pre_phase(int layer, unsigned char* lds) {
    const Params p = get_params(); const int bid = BID(), nblk = NBLK();
    LAS float* zs = (LAS float*)lds; constexpr int TS = 2 * 64 * 65;
    const int tid = TID();
    const bf16_t* PH = (const bf16_t*)(p.ws + WS_PH); float* Z = (float*)(p.ws + WS_Z); bf16_t* X0T = (bf16_t*)(p.ws + WS_X0T);
    const float* cw = p.in[4] + (size_t)layer * 3 * 3072; const float* cb = p.in[5] + (size_t)layer * 3072;
    for (int tile0 = bid; tile0 < 4096; tile0 += 2 * nblk) {
        u32x4 xr[2][3][3];
#pragma unroll
        for (int u = 0; u < 2; ++u) { const int tile = tile0 + u * nblk; if (tile < 4096) {
            const int t0 = (tile >> 4) * 64, c0 = (tile & 15) * 64, tt = tid >> 3, cg8 = (tid & 7) * 8, t = t0 + tt, tl = t & (SEQL - 1);
#pragma unroll
            for (int g = 0; g < 3; ++g) { const bf16_t* pr = PH + (size_t)t * 3072 + g * 1024 + c0 + cg8; const u32x4 z4 = {0u, 0u, 0u, 0u};
                xr[u][g][0] = tl > 0 ? *(const u32x4*)(pr - 3072) : z4; xr[u][g][1] = *(const u32x4*)pr; xr[u][g][2] = tl < SEQL - 1 ? *(const u32x4*)(pr + 3072) : z4; } } }
        __syncthreads();
#pragma unroll
        for (int u = 0; u < 2; ++u) { const int tile = tile0 + u * nblk; if (tile < 4096) {
            const int c0 = (tile & 15) * 64, tt = tid >> 3, cg8 = (tid & 7) * 8;
            float o[3][8];
#pragma unroll
            for (int g = 0; g < 3; ++g) {
                const int ch = g * 1024 + c0 + cg8; const u32x4 xm = xr[u][g][0], xc = xr[u][g][1], xp = xr[u][g][2];
                const f32x4 w0a = *(const f32x4*)(cw + ch), w0b = *(const f32x4*)(cw + ch + 4);
                const f32x4 w1a = *(const f32x4*)(cw + 3072 + ch), w1b = *(const f32x4*)(cw + 3072 + ch + 4);
                const f32x4 w2a = *(const f32x4*)(cw + 6144 + ch), w2b = *(const f32x4*)(cw + 6144 + ch + 4);
                const f32x4 ba = *(const f32x4*)(cb + ch), bb = *(const f32x4*)(cb + ch + 4);
                o[g][0] = bf_lo(xm.x) * w0a[0] + bf_lo(xc.x) * w1a[0] + bf_lo(xp.x) * w2a[0] + ba[0];
                o[g][1] = bf_hi(xm.x) * w0a[1] + bf_hi(xc.x) * w1a[1] + bf_hi(xp.x) * w2a[1] + ba[1];
                o[g][2] = bf_lo(xm.y) * w0a[2] + bf_lo(xc.y) * w1a[2] + bf_lo(xp.y) * w2a[2] + ba[2];
                o[g][3] = bf_hi(xm.y) * w0a[3] + bf_hi(xc.y) * w1a[3] + bf_hi(xp.y) * w2a[3] + ba[3];
                o[g][4] = bf_lo(xm.z) * w0b[0] + bf_lo(xc.z) * w1b[0] + bf_lo(xp.z) * w2b[0] + bb[0];
                o[g][5] = bf_hi(xm.z) * w0b[1] + bf_hi(xc.z) * w1b[1] + bf_hi(xp.z) * w2b[1] + bb[1];
                o[g][6] = bf_lo(xm.w) * w0b[2] + bf_lo(xc.w) * w1b[2] + bf_lo(xp.w) * w2b[2] + bb[2];
                o[g][7] = bf_hi(xm.w) * w0b[3] + bf_hi(xc.w) * w1b[3] + bf_hi(xp.w) * w2b[3] + bb[3];
            }
            LAS float* zt = zs + u * TS; LAS float* xt = zt + 64 * 65;
#pragma unroll
            for (int e = 0; e < 8; ++e) { zt[(cg8 + e) * 65 + tt] = o[2][e] * o[1][e]; xt[(cg8 + e) * 65 + tt] = o[0][e]; } } }
        __syncthreads();
#pragma unroll
        for (int u = 0; u < 2; ++u) { const int tile = tile0 + u * nblk; if (tile < 4096) {
            const int t0 = (tile >> 4) * 64, c0 = (tile & 15) * 64;
            const int c = tid >> 3, tq = (tid & 7) * 8; const int bidx = t0 >> 13, tl0 = t0 & (SEQL - 1);
            const LAS float* zt = zs + u * TS; const LAS float* xt = zt + 64 * 65;
            float zv[8], xv[8];
#pragma unroll
            for (int e = 0; e < 8; ++e) { zv[e] = zt[c * 65 + tq + e]; xv[e] = xt[c * 65 + tq + e]; }
            const size_t off = ((size_t)(c0 + c) * 2 + bidx) * SEQL + tl0 + tq;
            *(f32x4*)(Z + off) = (f32x4){zv[0], zv[1], zv[2], zv[3]}; *(f32x4*)(Z + off + 4) = (f32x4){zv[4], zv[5], zv[6], zv[7]};
            u32x4 w; w.x = pk_bf16(xv[0], xv[1]); w.y = pk_bf16(xv[2], xv[3]); w.z = pk_bf16(xv[4], xv[5]); w.w = pk_bf16(xv[6], xv[7]);
            *(u32x4*)(X0T + off) = w; } }
    }
}

__device__ __forceinline__ void qk_rope_phase(int layer) {
    const Params p = get_params(); const int bid = BID(), nblk = NBLK();
    const int tid = TID(), sub = tid & 15;
    bf16_t* QKV = (bf16_t*)(p.ws + WS_QKV);
    const float* qn = p.in[13] + layer * HD; const float* kn = p.in[14] + layer * HD;
    const int vstride = nblk * 32;
    for (int vi0 = bid * 32 + (tid >> 4); vi0 < NTOK * 10; vi0 += 4 * vstride) {
        u32x4 w[4]; f32x4 tb[4][4]; f32x4 ga[4], gb[4];
#pragma unroll
        for (int u = 0; u < 4; ++u) { const int vi = vi0 + u * vstride; if (vi < NTOK * 10) {
            const int t = vi / 10, hh = vi - t * 10, tl = t & (SEQL - 1);
            w[u] = *(const u32x4*)(QKV + (size_t)t * 1536 + hh * HD + sub * 8);
            const int pos = (sub >> 3) == 0 ? (tl >> 6) : (tl & 63);
            const f32x4* tp = (const f32x4*)(p.ws + WS_ROPE) + (pos * 32 + (sub & 3) * 8) / 2;
#pragma unroll
            for (int e2 = 0; e2 < 4; ++e2) tb[u][e2] = tp[e2];
            const float* gp = (hh < 8 ? qn : kn) + sub * 8; ga[u] = *(const f32x4*)gp; gb[u] = *(const f32x4*)(gp + 4); } }
#pragma unroll
        for (int u = 0; u < 4; ++u) { const int vi = vi0 + u * vstride; if (vi < NTOK * 10) {
            const int t = vi / 10, hh = vi - t * 10;
            float x[8] = {bf_lo(w[u].x), bf_hi(w[u].x), bf_lo(w[u].y), bf_hi(w[u].y), bf_lo(w[u].z), bf_hi(w[u].z), bf_lo(w[u].w), bf_hi(w[u].w)};
            float ss = 0.f;
#pragma unroll
            for (int e = 0; e < 8; ++e) ss += x[e] * x[e];
            ss += __shfl_xor(ss, 1); ss += __shfl_xor(ss, 2); ss += __shfl_xor(ss, 4); ss += __shfl_xor(ss, 8);
            const float rs = rsqrtf(ss * (1.0f / HD) + RMS_EPS);
            x[0] *= rs * ga[u][0]; x[1] *= rs * ga[u][1]; x[2] *= rs * ga[u][2]; x[3] *= rs * ga[u][3]; x[4] *= rs * gb[u][0]; x[5] *= rs * gb[u][1]; x[6] *= rs * gb[u][2]; x[7] *= rs * gb[u][3];
            const bool hi_half = ((sub >> 2) & 1) != 0;
            float y[8];
#pragma unroll
            for (int e2 = 0; e2 < 4; ++e2) {
                const f32x4 cs = tb[u][e2];
                const float o0 = __shfl_xor(x[2 * e2], 4), o1 = __shfl_xor(x[2 * e2 + 1], 4);
                y[2 * e2]     = hi_half ? (x[2 * e2] * cs[0] + o0 * cs[1]) : (x[2 * e2] * cs[0] - o0 * cs[1]);
                y[2 * e2 + 1] = hi_half ? (x[2 * e2 + 1] * cs[2] + o1 * cs[3]) : (x[2 * e2 + 1] * cs[2] - o1 * cs[3]);
            }
            u32x4 o; o.x = pk_bf16(y[0], y[1]); o.y = pk_bf16(y[2], y[3]); o.z = pk_bf16(y[4], y[5]); o.w = pk_bf16(y[6], y[7]);
            *(u32x4*)(QKV + (size_t)t * 1536 + hh * HD + sub * 8) = o; } }
    }
}

__device__ __forceinline__ int fpad(int i) { return i + (i >> 4); }
__device__ __forceinline__ f32x2 cmul(f32x2 a, f32x2 b) { return (f32x2){a.x * b.x - a.y * b.y, a.x * b.y + a.y * b.x}; }
__device__ __forceinline__ constexpr float c16(int k) { return k == 0 ? 1.0f : k == 1 ? 0.9238795325112867f : k == 2 ? 0.7071067811865476f : k == 3 ? 0.3826834323650898f : k == 4 ? 0.0f : k == 5 ? -0.3826834323650898f : k == 6 ? -0.7071067811865476f : -0.9238795325112867f; }
__device__ __forceinline__ constexpr float s16(int k) { return k == 0 ? 0.0f : k == 1 ? 0.3826834323650898f : k == 2 ? 0.7071067811865476f : k == 3 ? 0.9238795325112867f : k == 4 ? 1.0f : k == 5 ? 0.9238795325112867f : k == 6 ? 0.7071067811865476f : 0.3826834323650898f; }

template <int LOGR, int SLOG, bool INV, bool HALF_IN = false, bool HALF_OUT = false>
__device__ __forceinline__ void fft_pass(LAS f32x2* X, int tid_in, const LAS f32x2* TW) {
    constexpr int R = 1 << LOGR, STRIDE = 1 << SLOG, NIT = FFTN / R, PER = (LOGR == 4 ? 1 : 2);
    const int tid = lv(tid_in);
#pragma unroll 1
    for (int w0 = tid; w0 < NIT; w0 += PER * NTHR) {
#pragma unroll
      for (int u = 0; u < PER; ++u) {
        const int w = w0 + u * NTHR;
        const int r = w & (STRIDE - 1), i0 = ((w >> SLOG) << (SLOG + LOGR)) + r;
        f32x2 v[R];
#pragma unroll
        for (int j = 0; j < (HALF_IN ? R / 2 : R); ++j) v[j] = X[fpad(i0 + j * STRIDE)];
        f32x2 wp[LOGR];
        if (SLOG == 0) {
#pragma unroll
            for (int s = 0; s < LOGR; ++s) wp[s] = (f32x2){1.0f, 0.0f};
        } else {
            const f32x2 t0 = TW[r]; wp[0] = INV ? (f32x2){t0.x, -t0.y} : t0;
#pragma unroll
            for (int s = 1; s < LOGR; ++s) wp[s] = cmul(wp[s - 1], wp[s - 1]);
        }
        if (!INV) {
#pragma unroll
            for (int s = 0; s < LOGR; ++s) {
                const int half = R >> (s + 1);
#pragma unroll
                for (int j = 0; j < R; ++j) if ((j & half) == 0) {
                    const int jl = j & (half - 1), idx = jl * (8 / half);
                    f32x2 d;
                    if (HALF_IN && s == 0) { d = v[j]; }
                    else { const f32x2 a = v[j], b = v[j + half]; v[j] = a + b; d = a - b; }
                    if (SLOG == 0) { v[j + half] = idx == 0 ? d : cmul(d, (f32x2){c16(idx), -s16(idx)}); }
                    else { const f32x2 t = idx == 0 ? wp[s] : cmul(wp[s], (f32x2){c16(idx), -s16(idx)}); v[j + half] = cmul(d, t); } }
            }
        } else {
#pragma unroll
            for (int s = LOGR - 1; s >= 0; --s) {
                const int half = R >> (s + 1);
#pragma unroll
                for (int j = 0; j < R; ++j) if ((j & half) == 0) {
                    const int jl = j & (half - 1), idx = jl * (8 / half);
                    f32x2 b;
                    if (SLOG == 0) { b = idx == 0 ? v[j + half] : cmul(v[j + half], (f32x2){c16(idx), s16(idx)}); }
                    else { const f32x2 t = idx == 0 ? wp[s] : cmul(wp[s], (f32x2){c16(idx), s16(idx)}); b = cmul(v[j + half], t); }
                    const f32x2 a = v[j]; v[j] = a + b; if (!(HALF_OUT && s == 0)) v[j + half] = a - b; }
            }
        }
#pragma unroll
        for (int j = 0; j < (HALF_OUT ? R / 2 : R); ++j) X[fpad(i0 + j * STRIDE)] = v[j];
      }
    }
}
constexpr int TW_A = 0, TW_B = 1024, TW_C = 1024 + 128, TW_N = 1024 + 128 + 16;
__device__ __forceinline__ void fft_build_twiddles(LAS f32x2* TW, int tid) {
    for (int i = tid; i < TW_N; i += NTHR) {
        const int r = i < TW_B ? i : (i < TW_C ? i - TW_B : i - TW_C); const float den = i < TW_B ? (1.0f / 16384.0f) : (i < TW_C ? (1.0f / 1024.0f) : (1.0f / 128.0f));
        float sn, cs; sincospif(-2.0f * (float)r * den, &sn, &cs); TW[i] = (f32x2){cs, sn}; }
}
template <bool HALF_IN>
__device__ __forceinline__ void fft_fwd(LAS f32x2* X, int tid, const LAS f32x2* TW) {
    fft_pass<4, 10, false, HALF_IN>(X, tid, TW + TW_A); __syncthreads(); fft_pass<3, 7, false>(X, tid, TW + TW_B); __syncthreads(); fft_pass<3, 4, false>(X, tid, TW + TW_C); __syncthreads(); fft_pass<4, 0, false>(X, tid, TW); __syncthreads();
}
__device__ __forceinline__ void fft_inv_half(LAS f32x2* X, int tid, const LAS f32x2* TW) {
    fft_pass<4, 0, true>(X, tid, TW); __syncthreads(); fft_pass<3, 4, true>(X, tid, TW + TW_C); __syncthreads(); fft_pass<3, 7, true>(X, tid, TW + TW_B); __syncthreads(); fft_pass<4, 10, true, false, true>(X, tid, TW + TW_A); __syncthreads();
}

constexpr int KT_EARLY = 1280;
template <int PART>
__device__ __forceinline__ void ktime_phase(int layer, unsigned char* lds) {
    const Params p = get_params(); const int bid = BID(), nblk = NBLK(); const int tid = TID();
    LAS float* hT = (LAS float*)lds;
    LAS float* wT = hT + 64 * 132;
    const float* hdn = (const float*)(p.ws + WS_HDN) + (size_t)layer * SEQL * FHID;
    const float* w3 = p.in[10] + (size_t)layer * FHID * 2 * HYW; float* KT = p.out;
    const bool split = (nblk == 256);
    if (PART == 1 && (!split || bid < 128)) return;
    const int first = PART == 1 ? bid - 128 : (PART == 2 && split ? KT_EARLY + bid : bid), step = PART == 1 ? 128 : nblk, lim = PART == 1 ? KT_EARLY : 64 * 32;
    for (int tile = first; tile < lim; tile += step) {
        const int t0 = (tile >> 5) * 128, col0 = (tile & 31) * 64;
        __syncthreads();
        { f32x4 hq[4], wq[2];
#pragma unroll
          for (int q = 0; q < 4; ++q) { const int idx = q * NTHR + tid, tt = idx >> 4, j4 = (idx & 15) * 4;
              hq[q] = *(const f32x4*)(hdn + (size_t)(t0 + tt) * FHID + j4); }
#pragma unroll
          for (int q = 0; q < 2; ++q) { const int idx = q * NTHR + tid, j = idx >> 4, c4 = (idx & 15) * 4; wq[q] = *(const f32x4*)(w3 + (size_t)j * (2 * HYW) + col0 + c4); }
          asm volatile("" : "+v"(hq[0]), "+v"(hq[1]), "+v"(hq[2]), "+v"(hq[3]), "+v"(wq[0]), "+v"(wq[1]));
#pragma unroll
          for (int q = 0; q < 4; ++q) { const int idx = q * NTHR + tid, tt = idx >> 4, j4 = (idx & 15) * 4;
              hT[(j4 + 0) * 132 + tt] = hq[q][0]; hT[(j4 + 1) * 132 + tt] = hq[q][1]; hT[(j4 + 2) * 132 + tt] = hq[q][2]; hT[(j4 + 3) * 132 + tt] = hq[q][3]; }
#pragma unroll
          for (int q = 0; q < 2; ++q) { const int idx = q * NTHR + tid, j = idx >> 4, c4 = (idx & 15) * 4; *(LAS f32x4*)(wT + j * 64 + c4) = wq[q]; } }
        __syncthreads();
        const int tg = (tid & 31) * 4, cg4 = (tid >> 5) * 4;
        f32x4 acc[4] = {{0.f, 0.f, 0.f, 0.f}, {0.f, 0.f, 0.f, 0.f}, {0.f, 0.f, 0.f, 0.f}, {0.f, 0.f, 0.f, 0.f}};
#pragma unroll 8
        for (int j = 0; j < FHID; ++j) { const f32x4 h = *(const LAS f32x4*)(hT + j * 132 + tg), w = *(const LAS f32x4*)(wT + j * 64 + cg4);
            acc[0] += h * w[0]; acc[1] += h * w[1]; acc[2] += h * w[2]; acc[3] += h * w[3]; }
        __syncthreads();
#pragma unroll
        for (int ci = 0; ci < 4; ++ci) { const int c = (col0 + cg4 + ci) & (HYW - 1);
            const float dl = fabsf(-15.350567286626973f + (float)c * ((-3.0701134573253946f + 15.350567286626973f) / 1023.0f));
            f32x4 o;
#pragma unroll
            for (int ti = 0; ti < 4; ++ti) o[ti] = acc[ci][ti] * expf(-((float)(t0 + tg + ti) / (float)(SEQL - 1)) * dl);
            *(LAS f32x4*)(hT + (cg4 + ci) * 132 + tg) = o; }
        __syncthreads();
        { const int col = tid >> 3, ch = (tid & 7) * 16, c = (col0 + col) & (HYW - 1); const bool bwd = col0 >= HYW;
          f32x4 v[4];
#pragma unroll
          for (int q = 0; q < 4; ++q) v[q] = *(const LAS f32x4*)(hT + col * 132 + ch + 4 * q);
          float* dst = KT + (size_t)c * FFTN;
          if (!bwd) {
#pragma unroll
              for (int q = 0; q < 4; ++q) *(f32x4*)(dst + t0 + ch + 4 * q) = v[q];
          } else {
              float* d2 = dst + (2 * SEQL - 16) - (t0 + ch);
#pragma unroll
              for (int q = 0; q < 4; ++q) *(f32x4*)(d2 + 4 * q) = (f32x4){v[3 - q][3], v[3 - q][2], v[3 - q][1], v[3 - q][0]};
          } }
    }
}

__device__ __forceinline__ void fft_conv_phase(int layer, unsigned char* lds) {
    const Params p = get_params(); const int bid = BID(), nblk = NBLK();
    LAS f32x2* X = (LAS f32x2*)lds; LAS float* RED = (LAS float*)(lds + FFT_LDS);
    const int tid0 = TID(), wid = tid0 >> 6, lane = tid0 & 63;
    const float* skip = p.in[12] + layer * HYW; const float* KT = p.out;
    const float* Z = (const float*)(p.ws + WS_Z); const bf16_t* X0T = (const bf16_t*)(p.ws + WS_X0T);
    LAS f32x2* T = (LAS f32x2*)(lds + FFT_LDS + 1024);
    fft_build_twiddles(T, tid0);
    for (int c = bid; c < HYW; c += nblk) {
        __syncthreads();
        const int tid = lv(tid0);
        const float* kt = KT + (size_t)c * FFTN;
        float asum = 0.f;
        { float kv[32];
#pragma unroll
          for (int q = 0; q < 32; ++q) kv[q] = kt[q * NTHR + tid];
          PIN16F(kv, 0); PIN16F(kv, 16);
#pragma unroll
          for (int q = 0; q < 32; ++q) { asum += fabsf(kv[q]); X[fpad(q * NTHR + tid)] = (f32x2){kv[q], 0.f}; } }
#pragma unroll
        for (int o = 32; o > 0; o >>= 1) asum += __shfl_xor(asum, o);
        if (lane == 0) RED[wid] = asum;
        __syncthreads();
        float total = 0.f;
#pragma unroll
        for (int i = 0; i < 8; ++i) total += RED[i];
        fft_fwd<false>(X, tid, T);
        const float scale = 1.0f / ((float)FFTN * total);
        f32x2 kreg[32];
#pragma unroll
        for (int q = 0; q < 32; ++q) kreg[q] = X[fpad(q * NTHR + tid)] * scale;
        __syncthreads();
        const float* z0 = Z + (size_t)c * 2 * SEQL; const float* z1 = z0 + SEQL;
        { float za[16], zb[16];
#pragma unroll
          for (int q = 0; q < 16; ++q) { za[q] = z0[q * NTHR + tid]; zb[q] = z1[q * NTHR + tid]; }
          PIN16F(za, 0); PIN16F(zb, 0);
#pragma unroll
          for (int q = 0; q < 16; ++q) X[fpad(q * NTHR + tid)] = (f32x2){za[q], zb[q]}; }
        __syncthreads();
        fft_fwd<true>(X, tid, T);
#pragma unroll
        for (int q = 0; q < 32; ++q) { const int i = fpad(q * NTHR + tid); X[i] = cmul(X[i], kreg[q]); }
        __syncthreads();
        fft_inv_half(X, tid, T);
        const float sk = skip[c];
        const bf16_t* x00 = X0T + (size_t)c * 2 * SEQL; const bf16_t* x01 = x00 + SEQL;
        bf16_t* yt0 = (bf16_t*)(p.ws + WS_YT) + (size_t)c * 2 * SEQL; bf16_t* yt1 = yt0 + SEQL;
#pragma unroll
        for (int hq = 0; hq < 2; ++hq) {
            float za[8], zb[8]; unsigned xa[8], xb[8];
#pragma unroll
            for (int q = 0; q < 8; ++q) { const int t = (hq * 8 + q) * NTHR + tid; za[q] = z0[t]; zb[q] = z1[t]; xa[q] = x00[t]; xb[q] = x01[t]; }
            asm volatile("" : "+v"(za[0]), "+v"(za[1]), "+v"(za[2]), "+v"(za[3]), "+v"(za[4]), "+v"(za[5]), "+v"(za[6]), "+v"(za[7]), "+v"(zb[0]), "+v"(zb[1]), "+v"(zb[2]), "+v"(zb[3]), "+v"(zb[4]), "+v"(zb[5]), "+v"(zb[6]), "+v"(zb[7]));
            asm volatile("" : "+v"(xa[0]), "+v"(xa[1]), "+v"(xa[2]), "+v"(xa[3]), "+v"(xa[4]), "+v"(xa[5]), "+v"(xa[6]), "+v"(xa[7]), "+v"(xb[0]), "+v"(xb[1]), "+v"(xb[2]), "+v"(xb[3]), "+v"(xb[4]), "+v"(xb[5]), "+v"(xb[6]), "+v"(xb[7]));
#pragma unroll
            for (int q = 0; q < 8; ++q) { const int t = (hq * 8 + q) * NTHR + tid;
                const f32x2 y = X[fpad(t)];
                const float ya = __uint_as_float(xa[q] << 16) * (y.x + sk * za[q]), yb = __uint_as_float(xb[q] << 16) * (y.y + sk * zb[q]);
                yt0[t] = (bf16_t)(pk_bf16(ya, ya) & 0xffffu);
                yt1[t] = (bf16_t)(pk_bf16(yb, yb) & 0xffffu); }
        }
    }
}

__device__ __forceinline__ void ytrans_phase(unsigned char* lds) {
    const Params p = get_params(); const int bid = BID(), nblk = NBLK(); const int tid = TID();
    LAS float* T = (LAS float*)lds; constexpr int TS = 64 * 65, NT = 16 * 256;
    const bf16_t* YT = (const bf16_t*)(p.ws + WS_YT); bf16_t* YHY = (bf16_t*)(p.ws + WS_YHY);
    for (int id0 = bid; id0 < NT; id0 += 4 * nblk) {
        u32x4 w[4];
#pragma unroll
        for (int q = 0; q < 4; ++q) { const int id = id0 + q * nblk; if (id < NT) { const int t0 = (id >> 4) * 64, c0 = (id & 15) * 64, cc = tid >> 3, t8 = (tid & 7) * 8;
            w[q] = *(const u32x4*)(YT + ((size_t)(c0 + cc) * 2 + (t0 >> 13)) * SEQL + (t0 & (SEQL - 1)) + t8); } }
#pragma unroll
        for (int q = 0; q < 4; ++q) { const int id = id0 + q * nblk; if (id < NT) { const int cc = tid >> 3, t8 = (tid & 7) * 8; LAS float* d = T + q * TS + t8 * 65 + cc;
            d[0] = bf_lo(w[q].x); d[65] = bf_hi(w[q].x); d[130] = bf_lo(w[q].y); d[195] = bf_hi(w[q].y); d[260] = bf_lo(w[q].z); d[325] = bf_hi(w[q].z); d[390] = bf_lo(w[q].w); d[455] = bf_hi(w[q].w); } }
        __syncthreads();
#pragma unroll
        for (int q = 0; q < 4; ++q) { const int id = id0 + q * nblk; if (id < NT) { const int t0 = (id >> 4) * 64, c0 = (id & 15) * 64, tt = tid >> 3, c8 = (tid & 7) * 8; const LAS float* sp = T + q * TS + tt * 65 + c8;
            u32x4 o; o.x = pk_bf16(sp[0], sp[1]); o.y = pk_bf16(sp[2], sp[3]); o.z = pk_bf16(sp[4], sp[5]); o.w = pk_bf16(sp[6], sp[7]);
            *(u32x4*)(YHY + (size_t)(t0 + tt) * HYW + c0 + c8) = o; } }
        __syncthreads();
    }
}

__device__ __forceinline__ void attention_phase(unsigned char* lds) {
    const Params p = get_params(); const int bid = BID(), nblk = NBLK();
    const att::bf16* QKV = (const att::bf16*)(p.ws + WS_QKV); att::bf16* YAT = (att::bf16*)(p.ws + WS_YAT);
    for (int item = bid; item < NB * NH * (SEQL / 256); item += nblk) {
        const int b = item >> 8, h = (item >> 5) & 7, qb = item & 31, kvh = h >> 2;
        const att::bf16* Q = QKV + ((size_t)b * SEQL + qb * 256) * 1536 + h * HD;
        const att::bf16* K = QKV + ((size_t)b * SEQL) * 1536 + QW + kvh * HD;
        const att::bf16* V = K + KVW;
        att::bf16* O = YAT + ((size_t)b * SEQL + qb * 256) * QW + h * HD;
        __syncthreads();
        att::attn_dense_body<att::bf16>(Q, K, V, O, SEQL, (char*)lds);
    }
    __syncthreads();
}

#define XB_TMO      128
#define XB_XCNT(j)  (256  + 64 * (j))
#define XB_XSUB(j)  (1280 + 64 * (j))
#define XB_XGEN(j)  (2304 + 64 * (j))
#define XB_TOP      3328
#define XB_TOPGEN   3392
#define XCD_BAR_WORDS 3456
#define XB_SPIN_CAP (1u << 18)

__device__ __forceinline__ unsigned xb_ld(unsigned* p)              { return __hip_atomic_load(p, __ATOMIC_RELAXED, __HIP_MEMORY_SCOPE_AGENT); }
__device__ __forceinline__ unsigned xb_add(unsigned* p, unsigned v) { return __hip_atomic_fetch_add(p, v, __ATOMIC_RELAXED, __HIP_MEMORY_SCOPE_AGENT); }
__device__ __forceinline__ unsigned xb_xcc_id() { return (unsigned)__builtin_amdgcn_s_getreg((3 << 11) | 20) & 0xFu; }
#define XB_SPIN(cond, bar) do { unsigned _sp = 0; while (cond) { __builtin_amdgcn_s_sleep(1); \
    if ((++_sp & 255u) == 0u) { if (xb_ld(&(bar)[XB_TMO])) break; if (_sp > XB_SPIN_CAP) { atomicAdd(&(bar)[XB_TMO], 1u); break; } } } } while (0)

struct XcdBarrier {
    unsigned* bar; unsigned x;
    volatile LAS unsigned* st;
};

__device__ __forceinline__ XcdBarrier xcd_barrier_post(unsigned* bar, volatile LAS unsigned* st) {
    XcdBarrier b; b.bar = bar; b.x = xb_xcc_id(); b.st = st;
    if (threadIdx.x == 0) (void)xb_add(&bar[XB_XCNT(b.x)], 1u);
    return b;
}
__device__ __forceinline__ void xcd_barrier_complete(unsigned* bar, unsigned x, unsigned& nloc, unsigned& nx) {
    const unsigned G = gridDim.x * gridDim.y * gridDim.z;
    unsigned sum, cnt, mine, sp = 0u;
    for (;;) {
        sum = 0u; cnt = 0u; mine = 0u;
#pragma unroll
        for (unsigned j = 0; j < 16; ++j) { const unsigned c = xb_ld(&bar[XB_XCNT(j)]); sum += c; cnt += (c > 0u) ? 1u : 0u; mine = (j == x) ? c : mine; }
        if (sum == G) break;
        __builtin_amdgcn_s_sleep(1);
        if ((++sp & 255u) == 0u) { if (xb_ld(&bar[XB_TMO])) break; if (sp > XB_SPIN_CAP) { atomicAdd(&bar[XB_TMO], 1u); break; } }
    }
    nloc = mine > 0u ? mine : 1u; nx = cnt > 0u ? cnt : 1u;
}

__device__ __forceinline__ void xcd_barrier(const XcdBarrier& b) {
    asm volatile("s_waitcnt vmcnt(0)" ::: "memory");
    __syncthreads();
    if (threadIdx.x == 0) {
        unsigned* bar = b.bar;
        __builtin_amdgcn_s_waitcnt(0);
        unsigned nloc = b.st[0], nx = b.st[1];
        if (nloc == 0u) { xcd_barrier_complete(bar, b.x, nloc, nx); b.st[0] = nloc; b.st[1] = nx; }
        const unsigned old = xb_add(&bar[XB_XSUB(b.x)], 1u);
        const unsigned gen = old / nloc;
        if (old + 1u == (gen + 1u) * nloc) {
            __builtin_amdgcn_fence(__ATOMIC_RELEASE, "agent");
            asm volatile("s_waitcnt vmcnt(0)" ::: "memory");
            const unsigned og = xb_add(&bar[XB_TOP], 1u);
            const unsigned tg = og / nx;
            if (og + 1u == (tg + 1u) * nx) xb_add(&bar[XB_TOPGEN], 1u);
            else XB_SPIN(xb_ld(&bar[XB_TOPGEN]) == tg, bar);
            __builtin_amdgcn_fence(__ATOMIC_ACQUIRE, "agent");
            xb_add(&bar[XB_XGEN(b.x)], 1u);
            asm volatile("s_waitcnt vmcnt(0)" ::: "memory");
        } else {
            XB_SPIN(xb_ld(&bar[XB_XGEN(b.x)]) == gen, bar);
            __builtin_amdgcn_fence(__ATOMIC_ACQUIRE, "agent");
            asm volatile("s_waitcnt vmcnt(0)" ::: "memory");
        }
    }
    __syncthreads();
}
__device__ __forceinline__ LnFold make_fold(const Params& p, int sid, int gi, int bi, int glayer, bool is_in) {
    LnFold f; f.stats = sid < 0 ? nullptr : (const float*)(p.ws + WS_STATS) + (size_t)sid * NTOK * 2;
    f.g = p.in[gi] + (size_t)glayer * DM; f.b = p.in[bi] + (size_t)glayer * DM;
    f.pu = (const float*)(p.ws + (is_in ? WS_PUIN : WS_PUUP)); f.pv = (const float*)(p.ws + (is_in ? WS_PVIN : WS_PVUP)); return f;
}
constexpr size_t OUT_RB = (size_t)NTOK * DM * 2;
template <int MODE>
__device__ __forceinline__ void gemm_step(unsigned char* lds, int a_sel, size_t a_off, size_t b_off, int N, int K, int o_sel, size_t o_off, int ldc, int g_sel, size_t g_off, int gofs,
                                          int sid, int gi, int bi, int glayer, bool is_in, int sid_out) {
    const Params p = get_params(); unsigned char* ws = p.ws; unsigned char* od = (unsigned char*)p.out;
    EpiX<MODE> E{(bf16_t*)((o_sel ? od : ws) + o_off), ldc, (bf16_t*)(ws + WS_QKV), (bf16_t*)(ws + WS_G), (const bf16_t*)((g_sel ? od : ws) + g_off), gofs,
                 make_fold(p, sid, gi, bi, glayer, is_in), sid_out < 0 ? nullptr : (float*)(ws + WS_STATS) + (size_t)sid_out * NTOK * 2};
    const bf16_t* A = (const bf16_t*)((a_sel ? od : ws) + a_off);
    if constexpr (MODE == 6) run_gemm<MODE>(lds, A, (const bf16_t*)(ws + b_off), N, K, E, (const bf16_t*)(ws + WS_YAT), (const bf16_t*)(ws + WS_WAT));
    else run_gemm<MODE>(lds, A, (const bf16_t*)(ws + b_off), N, K, E);
}
#define GRID_BAR() xcd_barrier(xbar)
__global__ void __launch_bounds__(NTHR) hyena_gqa_mega(Params p_unused) {
    extern __shared__ __attribute__((aligned(16))) unsigned char lds[];
    cg::grid_group grid = cg::this_grid();

    volatile LAS unsigned* xst = (volatile LAS unsigned*)(lds + XST_OFF);
    if (threadIdx.x < 2) xst[threadIdx.x] = 0u;
    { const Params p = get_params();
      if (blockIdx.x == 0) { unsigned* bw = (unsigned*)(p.ws + WS_BAR); for (int i = threadIdx.x; i < XCD_BAR_WORDS; i += NTHR) bw[i] = 0u; }
      float* st = (float*)(p.ws + WS_STATS); for (int i = blockIdx.x * NTHR + threadIdx.x; i < 3 * NTOK * 2; i += gridDim.x * NTHR) st[i] = 0.f; }
    for (int rep = 0; rep < REP_CONV; ++rep) convert_weights_phase(0, lds);
    ln_phase<0>(1, 2, 0);
    hdn_phase(lds);
    grid.sync();
    XcdBarrier xbar;
    { const Params p = get_params(); xbar = xcd_barrier_post((unsigned*)(p.ws + WS_BAR), xst); }

#pragma nounroll
    for (int layer = 0; layer < DEPTH; ++layer) {
        const int sid_in = layer == 0 ? -1 : 1, sid_mid = layer == 0 ? 0 : 2, lprev = layer == 0 ? 0 : layer - 1;
        for (int rep = 0; rep < REP_PROJ; ++rep) gemm_step<0>(lds, 0, WS_HB, WS_WIN, NIN, DM, 0, WS_PH, 3072, 0, WS_G, 0, sid_in, 22, 23, lprev, true, -1);
        ktime_phase<1>(layer, lds);
        GRID_BAR();
        for (int rep = 0; rep < REP_HPRE; ++rep) hyena_pre_phase(layer, lds);
        qk_rope_phase(layer);
        for (int rep = 0; rep < REP_KT; ++rep) ktime_phase<2>(layer, lds);
        GRID_BAR();
        for (int rep = 0; rep < REP_FFT; ++rep) fft_conv_phase(layer, lds);
        for (int rep = 0; rep < REP_ATT; ++rep) attention_phase(lds);
        GRID_BAR();
        ytrans_phase(lds);
        GRID_BAR();
        for (int rep = 0; rep < REP_P4; ++rep) gemm_step<6>(lds, 0, WS_YHY, WS_WHY, DM, HYW, 0, WS_MRG, DM, 0, WS_G, DM, -1, 22, 23, 0, true, -1);
        GRID_BAR();
        for (int rep = 0; rep < REP_WO; ++rep) gemm_step<5>(lds, 0, WS_MRG, WS_WO, DM, DM, 0, WS_RB, DM, 0, WS_HB, 0, sid_in, 22, 23, lprev, true, sid_mid);
        GRID_BAR();
        for (int rep = 0; rep < REP_UP; ++rep) gemm_step<4>(lds, 0, WS_RB, WS_WUP, DFF, DM, 0, WS_FF, DFF, 0, WS_G, 0, sid_mid, 18, 19, layer, false, -1);
        GRID_BAR();
        for (int rep = 0; rep < REP_DOWN; ++rep) gemm_step<5>(lds, 0, WS_FF, WS_WDN, DM, DFF, 0, WS_HB, DM, 0, WS_RB, 0, sid_mid, 18, 19, layer, false, layer + 1 < DEPTH ? 1 : -1);
        GRID_BAR();
        if (layer + 1 < DEPTH) { convert_weights_phase(layer + 1, lds); GRID_BAR(); }
        else ln_phase<2>(22, 23, layer);
    }
}

extern "C" void kernel_launch(void* const* d_in, const int* in_sizes, int n_in, void* d_out, int out_size, void* d_ws, size_t ws_size, hipStream_t stream) {
    static int grid_blocks = 0;
    if (grid_blocks == 0) {
        if (n_in != 24 || out_size != NTOK * DM || ws_size < WS_END) { fprintf(stderr, "kernel_launch: unexpected shapes (n_in %d out %d ws %zu need %zu)\n", n_in, out_size, ws_size, (size_t)WS_END); grid_blocks = -1; return; }
        int dev = 0, cus = 0, per_cu = 0;
        hipGetDevice(&dev); hipDeviceGetAttribute(&cus, hipDeviceAttributeMultiprocessorCount, dev);
        if (hipFuncSetAttribute((const void*)hyena_gqa_mega, hipFuncAttributeMaxDynamicSharedMemorySize, LDS_BYTES) != hipSuccess) { fprintf(stderr, "kernel_launch: hipFuncSetAttribute failed\n"); grid_blocks = -1; return; }
        hipOccupancyMaxActiveBlocksPerMultiprocessor(&per_cu, (const void*)hyena_gqa_mega, NTHR, LDS_BYTES);
        if (per_cu < 1) { fprintf(stderr, "kernel_launch: occupancy query says 0 blocks/CU\n"); per_cu = 1; }
        grid_blocks = cus * per_cu;
    }
    if (grid_blocks < 0) return;
    Params p{};
    for (int i = 0; i < 24; ++i) p.in[i] = (const float*)d_in[i];
    p.out = (float*)d_out; p.ws = (unsigned char*)d_ws;
    void* args[] = {&p};
    hipError_t e = hipLaunchCooperativeKernel((const void*)hyena_gqa_mega, dim3(grid_blocks), dim3(NTHR), args, LDS_BYTES, stream);
    if (e != hipSuccess) fprintf(stderr, "cooperative launch failed: %s (grid %d)\n", hipGetErrorString(e), grid_blocks);
}
```
